# Optimizing an MI355X kernel written in HIP

```python
import jax, jax.numpy as jnp
from jax import lax
import numpy as np

D_MODEL = 1024
BATCH = 8
SEQ = 4096
DEPTH = 2

HEAD_DIM = 64
N_SB_HEADS = 12
SB_WIDTH = N_SB_HEADS * HEAD_DIM
N_MEM_HEADS = 4
MEM_WIDTH = N_MEM_HEADS * HEAD_DIM
MEM_TOKENS = 256
MIX_WIDTH = SB_WIDTH + MEM_WIDTH
POOL_WINDOWS = (2, 4, 8, 16)
N_POOL_GROUPS = len(POOL_WINDOWS)
POOL_WIDTH = SB_WIDTH
POOL_GROUP = POOL_WIDTH // N_POOL_GROUPS
D_FF = -(-8 * D_MODEL // (3 * 256)) * 256
SB_BLOCK = 128
N_A_LAYERS = DEPTH // 2
N_B_LAYERS = DEPTH - N_A_LAYERS
EPS = 1e-6

kernel_name = "yoco_pool_stickbreak_hybrid"


def rmsnorm(x, g):
    xf = x.astype(jnp.float32)
    y = xf * lax.rsqrt(jnp.mean(xf * xf, axis=-1, keepdims=True) + EPS)
    return (y * g.astype(jnp.float32)).astype(x.dtype)


def swiglu(h, w_gu, w_down):
    gate, up = jnp.split(h @ w_gu, 2, axis=-1)
    return (jax.nn.silu(gate) * up) @ w_down


def multiscale_pool(u):
    s = u.shape[1]
    uf = u.astype(jnp.float32)
    cs = jnp.cumsum(uf, axis=1)
    pos = jnp.arange(s)
    outs = []
    for g, w in enumerate(POOL_WINDOWS):
        c = cs[..., g * POOL_GROUP:(g + 1) * POOL_GROUP]
        prev = jnp.pad(c, ((0, 0), (w, 0), (0, 0)))[:, :s]
        cnt = jnp.minimum(pos + 1, w).astype(jnp.float32)[None, :, None]
        outs.append((c - prev) / cnt)
    pooled = jnp.concatenate(outs, axis=-1)
    return (pooled - uf).astype(u.dtype)


def memory_kv(mem, mem_norm, w_mem_kv):
    b, m, _ = mem.shape
    k, v = jnp.split(rmsnorm(mem, mem_norm) @ w_mem_kv, 2, axis=-1)
    return (k.reshape(b, m, N_MEM_HEADS, HEAD_DIM), v.reshape(b, m, N_MEM_HEADS, HEAD_DIM))


def memory_attention(q, mk, mv):
    b, s, _ = q.shape
    qh = q.reshape(b, s, N_MEM_HEADS, HEAD_DIM)
    logits = jnp.einsum("bshd,bmhd->bhsm", qh, mk).astype(jnp.float32) * (HEAD_DIM ** -0.5)
    p = jax.nn.softmax(logits, axis=-1).astype(mv.dtype)
    return jnp.einsum("bhsm,bmhd->bshd", p, mv).reshape(b, s, MEM_WIDTH)


def stick_breaking_attention(q, k, v):
    s = q.shape[2]
    scale = HEAD_DIM ** -0.5
    outs = []
    for i in range(s // SB_BLOCK):
        q0 = i * SB_BLOCK
        end = q0 + SB_BLOCK
        qb = q[:, :, q0:end]
        kb = k[:, :, :end]
        vb = v[:, :, :end]
        z = jnp.einsum("bhqd,bhkd->bhqk", qb, kb).astype(jnp.float32) * scale
        tpos = q0 + jnp.arange(SB_BLOCK)
        spos = jnp.arange(end)
        mask = spos[None, :] < tpos[:, None]
        log_not = jnp.where(mask, jax.nn.log_sigmoid(-z), 0.0)
        later = lax.cumsum(log_not, axis=3, reverse=True) - log_not
        wts = jnp.where(mask, jnp.exp(jax.nn.log_sigmoid(z) + later), 0.0)
        outs.append(jnp.einsum("bhqk,bhkd->bhqd", wts.astype(vb.dtype), vb))
    return jnp.concatenate(outs, axis=2)


def pool_layer(x, mem, mem_norm, norm_mix, w_in, w_group, scale, w_mem_kv, w_out, norm_ffn, w_gu, w_down):
    b, s, _ = x.shape
    proj = rmsnorm(x, norm_mix) @ w_in
    u_pool, q_mem = proj[..., :POOL_WIDTH], proj[..., POOL_WIDTH:]
    pooled = multiscale_pool(u_pool).reshape(b, s, N_POOL_GROUPS, POOL_GROUP)
    grouped = jnp.einsum("bsgc,gcd->bsgd", pooled, w_group).reshape(b, s, POOL_WIDTH) * scale
    mk, mv = memory_kv(mem, mem_norm, w_mem_kv)
    mem_out = memory_attention(q_mem, mk, mv)
    x = x + jnp.concatenate([grouped, mem_out], axis=-1) @ w_out
    return x + swiglu(rmsnorm(x, norm_ffn), w_gu, w_down)


def sb_layer(x, mem, k_sh, v_sh, mem_norm, norm_mix, w_q, w_mem_kv, w_out, norm_ffn, w_gu, w_down):
    b, s, _ = x.shape
    proj = rmsnorm(x, norm_mix) @ w_q
    q_sb = proj[..., :SB_WIDTH].reshape(b, s, N_SB_HEADS, HEAD_DIM).transpose(0, 2, 1, 3)
    q_mem = proj[..., SB_WIDTH:]
    sb_out = stick_breaking_attention(q_sb, k_sh, v_sh).transpose(0, 2, 1, 3).reshape(b, s, SB_WIDTH)
    mk, mv = memory_kv(mem, mem_norm, w_mem_kv)
    mem_out = memory_attention(q_mem, mk, mv)
    x = x + jnp.concatenate([sb_out, mem_out], axis=-1) @ w_out
    return x + swiglu(rmsnorm(x, norm_ffn), w_gu, w_down)


def setup_inputs(seed: int = 0) -> dict:
    key = jax.random.key(seed)
    ks = jax.random.split(key, 24)
    f32 = jnp.float32
    out_gain = (2.0 * DEPTH) ** -0.5

    def w(k, shape, fan_in, gain=1.0):
        return jax.random.normal(k, shape, f32) * (gain * fan_in ** -0.5)

    def g(k, shape):
        return 1.0 + 0.05 * jax.random.normal(k, shape, f32)

    na, nb = N_A_LAYERS, N_B_LAYERS
    return {
        "x": jax.random.normal(ks[0], (BATCH, SEQ, D_MODEL), f32),
        "mem": jax.random.normal(ks[1], (BATCH, MEM_TOKENS, D_MODEL), f32),
        "mem_norm": g(ks[2], (D_MODEL,)),
        "a_norm_mix": g(ks[3], (na, D_MODEL)),
        "a_w_in": w(ks[4], (na, D_MODEL, MIX_WIDTH), D_MODEL),
        "a_w_group": w(ks[5], (na, N_POOL_GROUPS, POOL_GROUP, POOL_GROUP), POOL_GROUP),
        "a_scale": g(ks[6], (na, POOL_WIDTH)),
        "a_w_mem_kv": w(ks[7], (na, D_MODEL, 2 * MEM_WIDTH), D_MODEL),
        "a_w_out": w(ks[8], (na, MIX_WIDTH, D_MODEL), MIX_WIDTH, out_gain),
        "a_norm_ffn": g(ks[9], (na, D_MODEL)),
        "a_w_gu": w(ks[10], (na, D_MODEL, 2 * D_FF), D_MODEL),
        "a_w_down": w(ks[11], (na, D_FF, D_MODEL), D_FF, out_gain),
        "kv_norm": g(ks[12], (D_MODEL,)),
        "w_kv": w(ks[13], (D_MODEL, 2 * SB_WIDTH), D_MODEL),
        "b_norm_mix": g(ks[14], (nb, D_MODEL)),
        "b_w_q": w(ks[15], (nb, D_MODEL, MIX_WIDTH), D_MODEL),
        "b_w_mem_kv": w(ks[16], (nb, D_MODEL, 2 * MEM_WIDTH), D_MODEL),
        "b_w_out": w(ks[17], (nb, MIX_WIDTH, D_MODEL), MIX_WIDTH, out_gain),
        "b_norm_ffn": g(ks[18], (nb, D_MODEL)),
        "b_w_gu": w(ks[19], (nb, D_MODEL, 2 * D_FF), D_MODEL),
        "b_w_down": w(ks[20], (nb, D_FF, D_MODEL), D_FF, out_gain),
        "final_norm": g(ks[21], (D_MODEL,)),
    }


def reference(x, mem, mem_norm, a_norm_mix, a_w_in, a_w_group, a_scale, a_w_mem_kv, a_w_out,
              a_norm_ffn, a_w_gu, a_w_down, kv_norm, w_kv, b_norm_mix, b_w_q, b_w_mem_kv,
              b_w_out, b_norm_ffn, b_w_gu, b_w_down, final_norm):
    b, s, _ = x.shape
    k_sh = v_sh = None
    for layer in range(DEPTH):
        if layer < N_A_LAYERS:
            i = layer
            x = pool_layer(x, mem, mem_norm, a_norm_mix[i], a_w_in[i], a_w_group[i], a_scale[i],
                           a_w_mem_kv[i], a_w_out[i], a_norm_ffn[i], a_w_gu[i], a_w_down[i])
        else:
            if layer == N_A_LAYERS:
                kv = rmsnorm(x, kv_norm) @ w_kv
                k_sh = kv[..., :SB_WIDTH].reshape(b, s, N_SB_HEADS, HEAD_DIM).transpose(0, 2, 1, 3)
                v_sh = kv[..., SB_WIDTH:].reshape(b, s, N_SB_HEADS, HEAD_DIM).transpose(0, 2, 1, 3)
            j = layer - N_A_LAYERS
            x = sb_layer(x, mem, k_sh, v_sh, mem_norm, b_norm_mix[j], b_w_q[j], b_w_mem_kv[j],
                         b_w_out[j], b_norm_ffn[j], b_w_gu[j], b_w_down[j])
    return rmsnorm(x, final_norm)
```

```cpp
#include <hip/hip_runtime.h>
#include <hip/hip_cooperative_groups.h>
#include <cstdio>
#include <cstdint>
namespace cg = cooperative_groups;
namespace pg8 {
#define PG8_LAS __attribute__((address_space(3)))
typedef unsigned short bf16_t;
typedef short bf16x8 __attribute__((ext_vector_type(8)));
typedef float f32x4 __attribute__((ext_vector_type(4)));
typedef unsigned u32x4 __attribute__((ext_vector_type(4)));
constexpr int BM = 256, BK = 64, HALF = 128, HTB = HALF * BK * 2  , STAGE_BYTES = 8 * HTB, NXCD = 8, WGM = 8;

__host__ __device__ __forceinline__ int lds_byte(int r, int c) { const int st = (r >> 4) * 2 + (c >> 5), rr = r & 15, cc = c & 31, ob = rr * 64 + cc * 2; return st * 1024 + (ob ^ (((ob >> 9) & 1) << 5)); }
__host__ __device__ __forceinline__ void stage_rc(int b, int& R, int& C) { const int st = b / 1024, sb = b % 1024, swz = sb ^ (((sb >> 9) & 1) << 5); R = (st >> 1) * 16 + swz / 64; C = (st & 1) * 32 + (swz % 64) / 2; }
__host__ __device__ __forceinline__ int perm32(int rho) { const int n = rho >> 4, i = rho & 15; return 8 * (i >> 2) + 4 * n + (i & 3); }

struct Unit { int pm, pn; };
struct Gemm { const bf16_t* A; const bf16_t* Bt; int M, N, K; };

struct StaticOrder {
    int nM, nN, nwg, G, c;
    __host__ __device__ void init(int M, int N, int G_, int c_) { nM = M / BM; nN = N / BM; nwg = nM * nN; G = G_; c = c_; }
    __host__ __device__ bool next(int i, Unit& u) const { return at((long)i * G + c, u); }
    __host__ __device__ bool at(const long L, Unit& u) const {
        if (L >= nwg) return false;
        int wgid = (int)L; { const int q = nwg / NXCD, r = nwg % NXCD, xcd = wgid % NXCD, off = wgid / NXCD; wgid = (xcd < r ? xcd * (q + 1) : r * (q + 1) + (xcd - r) * q) + off; }
        const int nig = WGM * nN, gid = wgid / nig, fm = gid * WGM, gsz = (nM - fm) < WGM ? (nM - fm) : WGM;
        u.pm = fm + ((wgid % nig) % gsz); u.pn = (wgid % nig) / gsz; return true;
    }
    __device__ __forceinline__ void a_ready(const Unit&) const {}
    __device__ __forceinline__ void done(const Unit&) const {}
};
typedef float f32x2 __attribute__((ext_vector_type(2)));
typedef __bf16 bf16x2_t __attribute__((ext_vector_type(2)));
__device__ __forceinline__ unsigned cvt_pk_bf16(float lo, float hi) { f32x2 v = {lo, hi}; bf16x2_t b = __builtin_convertvector(v, bf16x2_t); return __builtin_bit_cast(unsigned, b); }
__device__ __forceinline__ float rstd_of(float ss) { return __builtin_amdgcn_rsqf(ss * (1.0f / 1024.0f) + 1e-6f); }

struct EpiScale {
    static constexpr bool PERM = true, AFTER_DRAIN = false;
    bf16_t* O0; bf16_t* O1; const float* rss; const float* css; int ld0, ld1, csplit; float sc1; int vtb, fseq, fnh;
    __device__ __forceinline__ void operator()(const f32x4 (&acc)[2][2][4][2], const Unit& u, int wr, int wc, int fr, int fq) const {
        int colt = u.pn * BM; bf16_t* base = O0; int ld = ld0; float sc = 1.f;
        if (colt >= csplit) { base = O1; ld = ld1; colt -= csplit; sc = sc1; }
        const int col0 = colt + wc * 32 + 8 * fq, gcol0 = u.pn * BM + wc * 32 + 8 * fq;
        const int row0 = u.pm * BM + wr * 64 + fr;
        f32x4 cs[2][2];
#pragma unroll
        for (int bj = 0; bj < 2; ++bj)
#pragma unroll
            for (int n = 0; n < 2; ++n) {
                if (css) { const f32x4 s = *(const f32x4*)(css + gcol0 + bj * HALF + 4 * n); cs[bj][n] = (f32x4){rstd_of(s[0]) * sc, rstd_of(s[1]) * sc, rstd_of(s[2]) * sc, rstd_of(s[3]) * sc}; }
                else cs[bj][n] = (f32x4){sc, sc, sc, sc};
            }
        float rsv[2][4];
#pragma unroll
        for (int ai = 0; ai < 2; ++ai)
#pragma unroll
            for (int m = 0; m < 4; ++m) rsv[ai][m] = rss ? rss[row0 + ai * HALF + m * 16] : 0.f;
#pragma unroll
        for (int ai = 0; ai < 2; ++ai)
#pragma unroll
            for (int m = 0; m < 4; ++m) rsv[ai][m] = rss ? rstd_of(rsv[ai][m]) : 1.f;
        size_t a00; int sA, sM1, sM0, sBJ;
        { const int row = row0;
          if (vtb == 1) { const int hd = row >> 6, d = row & 63, bq = col0 >> fseq, pos = col0 & ((1 << fseq) - 1), di = d & 31, pd = (di & 0x13) | ((di & 4) << 1) | ((di & 8) >> 1);
              a00 = ((size_t)(((bq * fnh + hd) << (fseq - 6)) + (pos >> 6)) * 8 + (d >> 5) * 4 + ((pos >> 4) & 3)) * 512 + (pd + 32 * ((pos >> 3) & 1)) * 8;
              sA = (2 << (fseq - 6)) * 4096; sM1 = 4 * 512; sM0 = 128; sBJ = 2 * 4096; }
          else if (vtb == 2 && base == O0) { const int bq = row >> fseq, pos = row & ((1 << fseq) - 1), hd = col0 >> 6, d = col0 & 63, ki = pos & 31, pk = (ki & 0x13) | ((ki & 4) << 1) | ((ki & 8) >> 1);
              a00 = ((size_t)(((bq * fnh + hd) << (fseq - 6)) + (pos >> 6)) * 8 + ((pos >> 5) & 1) * 4 + (d >> 4)) * 512 + (pk + 32 * ((d >> 3) & 1)) * 8;
              sA = 16 * 512; sM1 = 4 * 512; sM0 = 128; sBJ = (2 * 64) << fseq; }
          else if (vtb == 3 && base == O0) { a00 = ((size_t)(row >> 5) * 48 + (col0 >> 4)) * 512 + ((row & 31) + 32 * ((col0 >> 3) & 1)) * 8;
              sA = 4 * 48 * 512; sM1 = 48 * 512; sM0 = 128; sBJ = 8 * 512; }
          else { a00 = (size_t)row * ld + col0; sA = 128 * ld; sM1 = 32 * ld; sM0 = 16 * ld; sBJ = HALF; } }
        bf16_t* const p00 = base + a00;
#pragma unroll
        for (int ai = 0; ai < 2; ++ai)
#pragma unroll
            for (int m = 0; m < 4; ++m) { const float rs = rsv[ai][m];
                bf16_t* rowp = p00 + (ai * sA + (m >> 1) * sM1 + (m & 1) * sM0);
#pragma unroll
                for (int bj = 0; bj < 2; ++bj) { const f32x4 v0 = acc[ai][bj][m][0] * cs[bj][0] * rs, v1 = acc[ai][bj][m][1] * cs[bj][1] * rs;
                    u32x4 w; w.x = cvt_pk_bf16(v0[0], v0[1]); w.y = cvt_pk_bf16(v0[2], v0[3]); w.z = cvt_pk_bf16(v1[0], v1[1]); w.w = cvt_pk_bf16(v1[2], v1[3]);
                    *(u32x4*)(rowp + bj * sBJ) = w; } }
    }
};
struct KqvOrder {
    static constexpr int XT0 = 336, N1 = 896, N2 = 384;
    StaticOrder s1, s2; int G, c;
    __device__ void init(int G_, int c_) { G = G_; c = c_; s1.init(32768, 1792, G_, c_); s2.init(768, 32768, G_, c_); }
    __device__ bool next(int i, Unit& u) const {
        const long L = (long)i * G + c;
        if (L < N1) { s1.at(L, u); u.pm += XT0; return true; }
        if (L < N1 + N2) { s2.at(L - N1, u); u.pm += 7; u.pn += XT0; return true; }
        return false;
    }
    __device__ __forceinline__ void a_ready(const Unit&) const {}
    __device__ __forceinline__ void done(const Unit&) const {}
};
struct EpiKqv {
    static constexpr bool PERM = true, AFTER_DRAIN = false;
    bf16_t* KBp; bf16_t* PROJp; bf16_t* VTp; const float* ss;
    __device__ __forceinline__ void operator()(const f32x4 (&acc)[2][2][4][2], const Unit& u, int wr, int wc, int fr, int fq) const {
        if (u.pm >= KqvOrder::XT0) { const EpiScale E{KBp, PROJp, ss, nullptr, 768, 1024, 768, 0.125f * 1.4426950408889634f, 2, 12, 12}; const Unit v{u.pm - KqvOrder::XT0, u.pn}; E(acc, v, wr, wc, fr, fq); }
        else { const EpiScale E{VTp, VTp, nullptr, ss, 32768, 32768, 1 << 30, 1.f, 1, 12, 12}; const Unit v{u.pm - 7, u.pn - KqvOrder::XT0}; E(acc, v, wr, wc, fr, fq); }
    }
};

__device__ __forceinline__ f32x2 swiglu_pk(f32x2 a, f32x2 b, float nrs, float rs2) {
    const f32x2 t = a * nrs;
    f32x2 ex; ex.x = __builtin_amdgcn_exp2f(t.x); ex.y = __builtin_amdgcn_exp2f(t.y);
    const f32x2 d = ex + 1.0f;
    f32x2 r; r.x = __builtin_amdgcn_rcpf(d.x); r.y = __builtin_amdgcn_rcpf(d.y);
    return ((a * b) * rs2) * r;
}
struct EpiSwiglu {
    static constexpr bool PERM = true, AFTER_DRAIN = false;
    bf16_t* H; const float* rss; int ldh;
    __device__ __forceinline__ void operator()(const f32x4 (&acc)[2][2][4][2], const Unit& u, int wr, int wc, int fr, int fq) const {
        const int col0 = u.pn * HALF + wc * 32 + 8 * fq, row0 = u.pm * BM + wr * 64 + fr;
        float rsv[2][4];
#pragma unroll
        for (int ai = 0; ai < 2; ++ai)
#pragma unroll
            for (int m = 0; m < 4; ++m) rsv[ai][m] = rss[row0 + ai * HALF + m * 16];
#pragma unroll
        for (int ai = 0; ai < 2; ++ai)
#pragma unroll
            for (int m = 0; m < 4; ++m) { const int row = row0 + ai * HALF + m * 16; const float rs = rstd_of(rsv[ai][m]), nrs = rs * -1.4426950408889634f, rs2 = rs * rs;
                const f32x4 g0 = acc[ai][0][m][0], g1 = acc[ai][0][m][1], u0 = acc[ai][1][m][0], u1 = acc[ai][1][m][1];
                const f32x2 h0 = swiglu_pk((f32x2){g0[0], g0[1]}, (f32x2){u0[0], u0[1]}, nrs, rs2), h1 = swiglu_pk((f32x2){g0[2], g0[3]}, (f32x2){u0[2], u0[3]}, nrs, rs2),
                            h2 = swiglu_pk((f32x2){g1[0], g1[1]}, (f32x2){u1[0], u1[1]}, nrs, rs2), h3 = swiglu_pk((f32x2){g1[2], g1[3]}, (f32x2){u1[2], u1[3]}, nrs, rs2);
                u32x4 w; w.x = cvt_pk_bf16(h0.x, h0.y); w.y = cvt_pk_bf16(h1.x, h1.y); w.z = cvt_pk_bf16(h2.x, h2.y); w.w = cvt_pk_bf16(h3.x, h3.y);
                __builtin_nontemporal_store(w, (u32x4*)(H + (size_t)row * ldh + col0)); }
    }
};
__device__ __forceinline__ f32x4 bf_lo4(const u32x4& h, int half) { const unsigned a = half ? h.z : h.x, b = half ? h.w : h.y;
    return (f32x4){__uint_as_float(a << 16), __uint_as_float(a & 0xffff0000u), __uint_as_float(b << 16), __uint_as_float(b & 0xffff0000u)}; }
template <bool F32BASE> struct EpiResid {
    static constexpr bool PERM = true, AFTER_DRAIN = false;
    const float* base; bf16_t* XH; float* ss;
    __device__ __forceinline__ void operator()(const f32x4 (&acc)[2][2][4][2], const Unit& u, int wr, int wc, int fr, int fq) const {
        unsigned off0 = (unsigned)((u.pm * BM + wr * 64 + fr) * 1024 + u.pn * BM + wc * 32 + 8 * fq);
        asm volatile("" : "+v"(off0));
        if constexpr (F32BASE) {
#pragma unroll
            for (int ai = 0; ai < 2; ++ai) {
                f32x4 pre[4][2][2]; u32x4 w[4][2]; float sq[4];
#pragma unroll
                for (int m = 0; m < 4; ++m)
#pragma unroll
                    for (int bj = 0; bj < 2; ++bj) { const unsigned off = off0 + (unsigned)((ai * HALF + m * 16) * 1024 + bj * HALF);
                        pre[m][bj][0] = *(const f32x4*)(base + off); pre[m][bj][1] = *(const f32x4*)(base + off + 4); }
#pragma unroll
                for (int m = 0; m < 4; ++m) { float s = 0.f;
#pragma unroll
                    for (int bj = 0; bj < 2; ++bj) { const f32x4 v0 = pre[m][bj][0] + acc[ai][bj][m][0], v1 = pre[m][bj][1] + acc[ai][bj][m][1];
                        w[m][bj].x = cvt_pk_bf16(v0[0], v0[1]); w[m][bj].y = cvt_pk_bf16(v0[2], v0[3]); w[m][bj].z = cvt_pk_bf16(v1[0], v1[1]); w[m][bj].w = cvt_pk_bf16(v1[2], v1[3]);
                        s += (v0[0] * v0[0] + v0[1] * v0[1]) + (v0[2] * v0[2] + v0[3] * v0[3]) + (v1[0] * v1[0] + v1[1] * v1[1]) + (v1[2] * v1[2] + v1[3] * v1[3]); }
                    s += __shfl_xor(s, 16); s += __shfl_xor(s, 32); sq[m] = s; }
                __builtin_amdgcn_sched_barrier(0);
#pragma unroll
                for (int m = 0; m < 4; ++m) {
#pragma unroll
                    for (int bj = 0; bj < 2; ++bj) *(u32x4*)(XH + off0 + (unsigned)((ai * HALF + m * 16) * 1024 + bj * HALF)) = w[m][bj];
                    if (fq == 0) __hip_atomic_fetch_add(ss + (off0 >> 10) + ai * HALF + m * 16, sq[m], __ATOMIC_RELAXED, __HIP_MEMORY_SCOPE_AGENT); }
                __builtin_amdgcn_sched_barrier(0);
            }
        } else {
            u32x4 pre[2][4][2]; float sq[2][4];
#pragma unroll
            for (int ai = 0; ai < 2; ++ai)
#pragma unroll
                for (int m = 0; m < 4; ++m)
#pragma unroll
                    for (int bj = 0; bj < 2; ++bj) pre[ai][m][bj] = *(const u32x4*)(XH + off0 + (unsigned)((ai * HALF + m * 16) * 1024 + bj * HALF));
#pragma unroll
            for (int ai = 0; ai < 2; ++ai)
#pragma unroll
                for (int m = 0; m < 4; ++m) { float s = 0.f;
#pragma unroll
                    for (int bj = 0; bj < 2; ++bj) { const f32x4 v0 = bf_lo4(pre[ai][m][bj], 0) + acc[ai][bj][m][0], v1 = bf_lo4(pre[ai][m][bj], 1) + acc[ai][bj][m][1];
                        u32x4 w; w.x = cvt_pk_bf16(v0[0], v0[1]); w.y = cvt_pk_bf16(v0[2], v0[3]); w.z = cvt_pk_bf16(v1[0], v1[1]); w.w = cvt_pk_bf16(v1[2], v1[3]); pre[ai][m][bj] = w;
                        s += (v0[0] * v0[0] + v0[1] * v0[1]) + (v0[2] * v0[2] + v0[3] * v0[3]) + (v1[0] * v1[0] + v1[1] * v1[1]) + (v1[2] * v1[2] + v1[3] * v1[3]); }
                    s += __shfl_xor(s, 16); s += __shfl_xor(s, 32); sq[ai][m] = s; }
            __builtin_amdgcn_sched_barrier(0);
#pragma unroll
            for (int ai = 0; ai < 2; ++ai)
#pragma unroll
                for (int m = 0; m < 4; ++m) {
#pragma unroll
                    for (int bj = 0; bj < 2; ++bj) *(u32x4*)(XH + off0 + (unsigned)((ai * HALF + m * 16) * 1024 + bj * HALF)) = pre[ai][m][bj];
                    if (fq == 0) __hip_atomic_fetch_add(ss + (off0 >> 10) + ai * HALF + m * 16, sq[ai][m], __ATOMIC_RELAXED, __HIP_MEMORY_SCOPE_AGENT); }
        }
    }
};

template <class Epi, class Sched, bool ALIGN_EPI = false, bool SP2 = false>
__device__ __forceinline__ void gemm_phase(PG8_LAS unsigned char* lds, const Gemm g, const Sched& S, const Epi& E) {
    int tid_ = threadIdx.x; asm volatile("" : "+v"(tid_));
    const int tid = tid_, wid = __builtin_amdgcn_readfirstlane(tid >> 6), lane = tid & 63, wr = wid >> 2, wc = wid & 3, fr = lane & 15, fq = lane >> 4;
    const int K = g.K, nt = K / BK;
    unsigned voffA[2], voffB[2];
#pragma unroll
    for (int i = 0; i < 2; ++i) { int R, C; stage_rc(tid * 16 + i * 8192, R, C); const int Rb = Epi::PERM ? ((R & ~31) + perm32(R & 31)) : R;
        voffA[i] = (unsigned)(R * K + C) * 2u; voffB[i] = (unsigned)(Rb * K + C) * 2u; }
    const size_t kstep = (size_t)(BK * 2);
    const size_t hstep = (size_t)HALF * K * 2;
    const size_t tstep = 2 * hstep;
    const unsigned ldsw = (unsigned)wid * 1024u;
    const int aoff = lds_byte(wr * 64 + fr, fq * 8), boff = lds_byte(wc * 32 + fr, fq * 8);
#define PG8_SA(b, h) (((b) * 2 + (h)) * HTB)
#define PG8_SB(b, h) ((4 + (b) * 2 + (h)) * HTB)
#define PG8_STAGE(bufoff, gbase, voff) do { _Pragma("unroll") for (int _i = 0; _i < 2; ++_i) \
        __builtin_amdgcn_global_load_lds((const unsigned*)((const char*)(gbase) + (voff)[_i]), (PG8_LAS unsigned*)(lds + (bufoff) + ldsw + _i * 8192), 16, 0, 0); } while (0)
#define PG8_LDA(dst, b, h) do { _Pragma("unroll") for (int m = 0; m < 4; ++m) _Pragma("unroll") for (int k = 0; k < 2; ++k) dst[m][k] = *(const PG8_LAS bf16x8*)(lds + PG8_SA(b, h) + aoff + m * 2048 + k * 1024); } while (0)
#define PG8_LDB(dst, b, h) do { _Pragma("unroll") for (int n = 0; n < 2; ++n) _Pragma("unroll") for (int k = 0; k < 2; ++k) dst[n][k] = *(const PG8_LAS bf16x8*)(lds + PG8_SB(b, h) + boff + n * 2048 + k * 1024); } while (0)
#define PG8_MMA(ai, bj, At, Bt) do { __builtin_amdgcn_s_setprio(1); _Pragma("unroll") for (int m = 0; m < 4; ++m) _Pragma("unroll") for (int n = 0; n < 2; ++n) _Pragma("unroll") for (int k = 0; k < 2; ++k) \
        acc[ai][bj][m][n] = __builtin_amdgcn_mfma_f32_16x16x32_bf16(Bt[n][k], At[m][k], acc[ai][bj][m][n], 0, 0, 0); __builtin_amdgcn_s_setprio(0); } while (0)
#define PG8_WAIT_V(n) asm volatile("s_waitcnt vmcnt(" #n ")" ::: "memory")
#define PG8_WAIT_L(n) asm volatile("s_waitcnt lgkmcnt(" #n ")" ::: "memory")
#define PG8_BAR __builtin_amdgcn_s_barrier()
#define PG8_SCHED __builtin_amdgcn_sched_barrier(0)
    Unit cur, nxt; int ui = 0;
    if (!S.next(0, cur)) return;
    f32x4 acc[2][2][4][2];
#pragma unroll
    for (int a = 0; a < 2; ++a)
#pragma unroll
        for (int b = 0; b < 2; ++b)
#pragma unroll
            for (int m = 0; m < 4; ++m)
#pragma unroll
                for (int n = 0; n < 2; ++n) acc[a][b][m][n] = (f32x4){0.f, 0.f, 0.f, 0.f};
    bf16x8 At[4][2], B0[2][2], B1[2][2];
    const char* cA = (const char*)g.A + (size_t)cur.pm * tstep; const char* cB = (const char*)g.Bt + (size_t)cur.pn * tstep;
    S.a_ready(cur);
    if constexpr (SP2) {
        PG8_STAGE(PG8_SB(0, 0), cB, voffB); PG8_STAGE(PG8_SB(0, 1), cB + hstep, voffB); PG8_STAGE(PG8_SA(0, 0), cA, voffA); PG8_STAGE(PG8_SA(0, 1), cA + hstep, voffA);
        if (wr == 1) PG8_BAR;
        PG8_WAIT_V(2); PG8_BAR;
        PG8_STAGE(PG8_SB(1, 0), cB + kstep, voffB); PG8_STAGE(PG8_SA(1, 0), cA + kstep, voffA); PG8_STAGE(PG8_SB(1, 1), cB + hstep + kstep, voffB);
        PG8_WAIT_V(6); PG8_BAR;
    } else {
        PG8_STAGE(PG8_SB(0, 0), cB, voffB); PG8_STAGE(PG8_SA(0, 0), cA, voffA); PG8_STAGE(PG8_SB(0, 1), cB + hstep, voffB); PG8_STAGE(PG8_SA(0, 1), cA + hstep, voffA);
        if (wr == 1) PG8_BAR;
        PG8_WAIT_V(4); PG8_BAR;
        PG8_STAGE(PG8_SB(1, 0), cB + kstep, voffB); PG8_STAGE(PG8_SA(1, 0), cA + kstep, voffA); PG8_STAGE(PG8_SB(1, 1), cB + hstep + kstep, voffB);
        PG8_WAIT_V(6); PG8_BAR;
    }
    for (;;) {
        const bool has_next = S.next(ui + 1, nxt);
        const char* nA = has_next ? (const char*)g.A + (size_t)nxt.pm * tstep : cA; const char* nB = has_next ? (const char*)g.Bt + (size_t)nxt.pn * tstep : cB;
        for (int t = 0; t < nt; t += 2) {
            const bool last = (t == nt - 2);
            const char* a1 = cA + (size_t)(t + 1) * kstep;
            const char* a2 = last ? nA : cA + (size_t)(t + 2) * kstep; const char* b2 = last ? nB : cB + (size_t)(t + 2) * kstep;
            const char* a3 = a2 + kstep; const char* b3 = b2 + kstep;
            if (last && has_next) S.a_ready(nxt);
            if constexpr (SP2) {
            PG8_LDB(B0, 0, 0); PG8_LDB(B1, 0, 1); PG8_SCHED; PG8_LDA(At, 0, 0); PG8_STAGE(PG8_SA(1, 1), a1 + hstep, voffA);
            PG8_WAIT_V(8); PG8_WAIT_L(0); PG8_BAR; PG8_MMA(0, 0, At, B0); PG8_MMA(0, 1, At, B1); PG8_BAR; PG8_SCHED;
            PG8_LDA(At, 0, 1); PG8_STAGE(PG8_SB(0, 0), b2, voffB); PG8_STAGE(PG8_SB(0, 1), b2 + hstep, voffB); PG8_STAGE(PG8_SA(0, 0), a2, voffA);
            PG8_WAIT_V(8); PG8_WAIT_L(0); PG8_BAR; PG8_MMA(1, 0, At, B0); PG8_MMA(1, 1, At, B1); PG8_BAR; PG8_SCHED;
            PG8_LDB(B0, 1, 0); PG8_LDB(B1, 1, 1); PG8_SCHED; PG8_LDA(At, 1, 0); PG8_STAGE(PG8_SA(0, 1), a2 + hstep, voffA);
            PG8_WAIT_V(8); PG8_WAIT_L(0); PG8_BAR; PG8_MMA(0, 0, At, B0); PG8_MMA(0, 1, At, B1); PG8_BAR; PG8_SCHED;
            PG8_LDA(At, 1, 1); PG8_STAGE(PG8_SB(1, 0), b3, voffB); PG8_STAGE(PG8_SB(1, 1), b3 + hstep, voffB); PG8_STAGE(PG8_SA(1, 0), a3, voffA);
            PG8_WAIT_V(8); PG8_WAIT_L(0); PG8_BAR; PG8_MMA(1, 0, At, B0); PG8_MMA(1, 1, At, B1); PG8_BAR; PG8_SCHED;
            } else {
            PG8_LDB(B0, 0, 0); PG8_SCHED; PG8_LDA(At, 0, 0); PG8_STAGE(PG8_SA(1, 1), a1 + hstep, voffA);
            PG8_WAIT_L(8); PG8_BAR; PG8_WAIT_L(0); PG8_MMA(0, 0, At, B0); PG8_BAR; PG8_SCHED;
            PG8_LDB(B1, 0, 1); PG8_STAGE(PG8_SB(0, 0), b2, voffB);
            PG8_BAR; PG8_WAIT_L(0); PG8_MMA(0, 1, At, B1); PG8_BAR;
            PG8_LDA(At, 0, 1); PG8_STAGE(PG8_SA(0, 0), a2, voffA);
            PG8_BAR; PG8_WAIT_L(0); PG8_MMA(1, 0, At, B0); PG8_BAR; PG8_SCHED;
            PG8_STAGE(PG8_SB(0, 1), b2 + hstep, voffB);
            PG8_WAIT_V(6); PG8_BAR; PG8_MMA(1, 1, At, B1); PG8_BAR;
            PG8_LDB(B0, 1, 0); PG8_SCHED; PG8_LDA(At, 1, 0); PG8_STAGE(PG8_SA(0, 1), a2 + hstep, voffA);
            PG8_WAIT_L(8); PG8_BAR; PG8_WAIT_L(0); PG8_MMA(0, 0, At, B0); PG8_BAR; PG8_SCHED;
            PG8_LDB(B1, 1, 1); PG8_STAGE(PG8_SB(1, 0), b3, voffB);
            PG8_BAR; PG8_WAIT_L(0); PG8_MMA(0, 1, At, B1); PG8_BAR;
            PG8_LDA(At, 1, 1); PG8_STAGE(PG8_SA(1, 0), a3, voffA);
            PG8_BAR; PG8_WAIT_L(0); PG8_MMA(1, 0, At, B0); PG8_BAR; PG8_SCHED;
            PG8_STAGE(PG8_SB(1, 1), b3 + hstep, voffB);
            PG8_WAIT_V(6); PG8_BAR; PG8_MMA(1, 1, At, B1); PG8_BAR;
            }
        }
        if constexpr (ALIGN_EPI) { if (wr == 0) PG8_BAR; }
        if constexpr (!Epi::AFTER_DRAIN) { E(acc, cur, wr, wc, fr, fq); S.done(cur); }
        if (!has_next) break;
#pragma unroll
        for (int a = 0; a < 2; ++a)
#pragma unroll
            for (int b = 0; b < 2; ++b)
#pragma unroll
                for (int m = 0; m < 4; ++m)
#pragma unroll
                    for (int n = 0; n < 2; ++n) acc[a][b][m][n] = (f32x4){0.f, 0.f, 0.f, 0.f};
        cur = nxt; cA = nA; cB = nB; ++ui;
        if constexpr (ALIGN_EPI) { if (wr == 1) PG8_BAR; }
    }
    PG8_WAIT_V(0);
    if constexpr (!ALIGN_EPI) { if (wr == 0) PG8_BAR; }
    PG8_BAR;
    if constexpr (Epi::AFTER_DRAIN) { E.fused(acc, cur, wr, wc, fr, fq, lds, wid, lane); S.done(cur); }
#undef PG8_SA
#undef PG8_SB
#undef PG8_STAGE
#undef PG8_LDA
#undef PG8_LDB
#undef PG8_MMA
#undef PG8_WAIT_V
#undef PG8_WAIT_L
#undef PG8_BAR
#undef PG8_SCHED
}
}
constexpr int NB = 8, SEQ = 4096, T = NB * SEQ, DM = 1024, DFF = 2816, NMEM = 256, MROWS = NB * NMEM;
constexpr float C2 = 0.125f * 1.4426950408889634f;
constexpr float SB_EXIT = -160.0f;
constexpr size_t MiB = 1u << 20;
constexpr size_t WS_W_AIN = 1 * MiB, WS_W_AOUT = 3 * MiB, WS_W_AGU = 5 * MiB, WS_W_ADOWN = 16 * MiB, WS_W_MKV = 22 * MiB, WS_W_KQV = 24 * MiB,
                 WS_W_BOUT = 30 * MiB, WS_W_BGU = 32 * MiB, WS_W_BDOWN = 43 * MiB, WS_W_GRP = 49 * MiB, WS_MEMN = 50 * MiB, WS_MEMK = 54 * MiB, WS_MEMVT = 56 * MiB,
                 WS_SS = 58 * MiB, WS_XR = 64 * MiB, WS_XB = 192 * MiB, WS_PROJ = 256 * MiB, WS_MIX = 320 * MiB, WS_KB = 384 * MiB, WS_VT = 432 * MiB, WS_H = 256 * MiB, WS_END = 482 * MiB;
static_assert(WS_H + (size_t)T * DFF * 2 <= WS_VT, "h overlays PROJ|MIX|KB only");

namespace mix {
#define DI __device__ __forceinline__
typedef unsigned short bf16_t;
typedef short bf16x8 __attribute__((ext_vector_type(8)));
typedef float f32x16 __attribute__((ext_vector_type(16)));
typedef float f32x4 __attribute__((ext_vector_type(4)));
typedef unsigned u32x4 __attribute__((ext_vector_type(4)));
#define MFMA32(a, b, c) __builtin_amdgcn_mfma_f32_32x32x16_bf16((a), (b), (c), 0, 0, 0)
DI int pi32(int i) { return (i & 0x13) | ((i & 4) << 1) | ((i & 8) >> 1); }
DI unsigned pk2(float lo, float hi) { return pg8::cvt_pk_bf16(lo, hi); }
DI bf16x8 pack8(float a0, float a1, float a2, float a3, float a4, float a5, float a6, float a7) { u32x4 w; w.x = pk2(a0, a1); w.y = pk2(a2, a3); w.z = pk2(a4, a5); w.w = pk2(a6, a7); return __builtin_bit_cast(bf16x8, w); }
#define PACK8(P, B) pack8(P[(B)], P[(B) + 1], P[(B) + 2], P[(B) + 3], P[(B) + 4], P[(B) + 5], P[(B) + 6], P[(B) + 7])
DI bf16x8 ld8(const bf16_t* p) { return *(const bf16x8*)p; }
DI bf16x8 ldo(const void* base, unsigned off) { return *(const bf16x8*)((const char*)base + off); }
DI void sto8(void* base, unsigned off, const f32x16& o, int b) { u32x4 w; w.x = pk2(o[b], o[b + 1]); w.y = pk2(o[b + 2], o[b + 3]); w.z = pk2(o[b + 4], o[b + 5]); w.w = pk2(o[b + 6], o[b + 7]); *(u32x4*)((char*)base + off) = w; }
DI void halves(float v, float& lo, float& hi) { auto rr = __builtin_amdgcn_permlane32_swap(__float_as_uint(v), __float_as_uint(v), false, false); lo = __uint_as_float(rr[0]); hi = __uint_as_float(rr[1]); }
DI void store_o8(bf16_t* p, const f32x16& o, int b) { u32x4 w; w.x = pk2(o[b], o[b + 1]); w.y = pk2(o[b + 2], o[b + 3]); w.z = pk2(o[b + 4], o[b + 5]); w.w = pk2(o[b + 6], o[b + 7]); *(u32x4*)p = w; }

template <bool MASKED> DI void sb_group(f32x16& P, const int B, const int keyb, const int t, float& gt) {
    float run = 1.f;
#pragma unroll
    for (int i = 7; i >= 0; --i) {
        const float e = __builtin_amdgcn_exp2f(__builtin_amdgcn_fmed3f(-P[B + i], -126.f, 126.f));
        float beta = __builtin_amdgcn_rcpf(1.0f + e), nb = e * beta;
        if (MASKED) { const bool valid = (keyb + i) < t; beta = valid ? beta : 0.f; nb = valid ? nb : 1.f; }
        P[B + i] = beta * run;
        run *= nb;
    }
    gt = run;
}
template <bool MASKED> DI void sb_tile(f32x16& p0, f32x16& p1, float& carry, const int key0, const int t, const int hh) {
    float g0, g1, g2, g3;
    sb_group<MASKED>(p0, 0, key0 + 8 * hh, t, g0); sb_group<MASKED>(p0, 8, key0 + 16 + 8 * hh, t, g1);
    sb_group<MASKED>(p1, 0, key0 + 32 + 8 * hh, t, g2); sb_group<MASKED>(p1, 8, key0 + 48 + 8 * hh, t, g3);
    float l0, h0, l1, h1, l2, h2, l3, h3; halves(g0, l0, h0); halves(g1, l1, h1); halves(g2, l2, h2); halves(g3, l3, h3);
    const float t3 = l3 * h3, t2 = l2 * h2, t1 = l1 * h1, t0 = l0 * h0;
    const float c3 = __builtin_amdgcn_exp2f(carry), c2 = c3 * t3, c1 = c2 * t2, c0 = c1 * t1;
    const float o0 = hh ? c0 : c0 * h0, o1 = hh ? c1 : c1 * h1, o2 = hh ? c2 : c2 * h2, o3 = hh ? c3 : c3 * h3;
#pragma unroll
    for (int i = 0; i < 8; ++i) { p0[i] *= o0; p0[8 + i] *= o1; p1[i] *= o2; p1[8 + i] *= o3; }
    carry += (__builtin_amdgcn_logf(t3) + __builtin_amdgcn_logf(t2)) + (__builtin_amdgcn_logf(t1) + __builtin_amdgcn_logf(t0));
}
template <bool MASKED> DI bool sb_step(bf16x8 (&kf)[2][4], const bf16x8 (&qf)[4], f32x16& o0, f32x16& o1, float& carry, const int j, const int t, const int hh,
                                       const bf16_t* ku, const bf16_t* vu, const unsigned loff) {
    const int key0 = j * 64;
    f32x16 p0 = {}, p1 = {};
#pragma unroll
    for (int s = 0; s < 4; ++s) { p0 = MFMA32(kf[0][s], qf[s], p0); p1 = MFMA32(kf[1][s], qf[s], p1); }
    bf16x8 vf[2][4];
#pragma unroll
    for (int dt = 0; dt < 2; ++dt)
#pragma unroll
        for (int s = 0; s < 4; ++s) vf[dt][s] = ldo(vu + (size_t)j * 4096, loff + (dt * 4 + s) * 1024);
    if (j > 0) {
#pragma unroll
        for (int hf = 0; hf < 2; ++hf)
#pragma unroll
            for (int s = 0; s < 4; ++s) kf[hf][s] = ldo(ku + (size_t)(j - 1) * 4096, loff + (hf * 4 + s) * 1024);
    }
    sb_tile<MASKED>(p0, p1, carry, key0, t, hh);
    const bf16x8 w0 = PACK8(p0, 0), w1 = PACK8(p0, 8), w2 = PACK8(p1, 0), w3 = PACK8(p1, 8);
    o0 = MFMA32(vf[0][0], w0, o0); o1 = MFMA32(vf[1][0], w0, o1);
    o0 = MFMA32(vf[0][1], w1, o0); o1 = MFMA32(vf[1][1], w1, o1);
    o0 = MFMA32(vf[0][2], w2, o0); o1 = MFMA32(vf[1][2], w2, o1);
    o0 = MFMA32(vf[0][3], w3, o0); o1 = MFMA32(vf[1][3], w3, o1);
    return j == 0 || __all(carry < SB_EXIT);
}
DI void sb_unit(const bf16_t* __restrict__ Q, const bf16_t* __restrict__ Kb, const bf16_t* __restrict__ VT, bf16_t* __restrict__ O, const int b, const int h, const int q0, int lane) {
    asm volatile("" : "+v"(lane));
    const int li = lane & 31, hh = lane >> 5, t = q0 + li;
    const size_t trow = (size_t)b * SEQ;
    const bf16_t* qu = Q + (trow + q0) * 1024 + h * 64;
    const bf16_t* ku = Kb + (size_t)(b * 12 + h) * (SEQ * 64);
    const bf16_t* vu = VT + (size_t)(b * 12 + h) * (SEQ * 64);
    bf16_t* ou = O + (trow + q0) * 1024 + h * 64;
    const unsigned qoff = (unsigned)(li * 1024 + hh * 8) * 2u, loff = (unsigned)lane * 16u;
    bf16x8 qf[4];
#pragma unroll
    for (int s = 0; s < 4; ++s) qf[s] = ldo(qu, qoff + 32 * s);
    f32x16 o0 = {}, o1 = {}; float carry = 0.f;
    int j = (q0 + 30) >> 6;
    bf16x8 kf[2][4];
#pragma unroll
    for (int hf = 0; hf < 2; ++hf)
#pragma unroll
        for (int s = 0; s < 4; ++s) kf[hf][s] = ldo(ku + (size_t)j * 4096, loff + (hf * 4 + s) * 1024);
    bool done = sb_step<true>(kf, qf, o0, o1, carry, j, t, hh, ku, vu, loff);
    while (!done) { --j; done = sb_step<false>(kf, qf, o0, o1, carry, j, t, hh, ku, vu, loff); }
    sto8(ou, qoff, o0, 0); sto8(ou, qoff + 32, o0, 8); sto8(ou, qoff + 64, o1, 0); sto8(ou, qoff + 96, o1, 8);
}
DI void memkv_unit(const bf16_t* __restrict__ MNF, const bf16_t* __restrict__ WF, bf16_t* __restrict__ MK, bf16_t* __restrict__ MVT, const int u, int lane) {
    asm volatile("" : "+v"(lane));
    const int li = lane & 31, hh = lane >> 5;
    const bool isv = u >= 1024; const int v = u & 1023, tt = v & 63, dt = (v >> 6) & 1, hd = v >> 7;
    const bf16_t* wt = WF + (size_t)(((isv ? 16 : 0) + hd * 2 + dt) * 64) * 512;
    const bf16_t* mt = MNF + (size_t)(tt * 64) * 512;
    const unsigned loff = (unsigned)lane * 16u, poff = (unsigned)(pi32(li) + 32 * hh) * 16u;
    const bf16_t* pa = isv ? mt : wt; const bf16_t* pb = isv ? wt : mt; const unsigned oa = isv ? poff : loff;
    f32x16 acc = {}, acc2 = {};
#pragma unroll 1
    for (int s0 = 0; s0 < 64; s0 += 16) {
        bf16x8 fa[16], fb[16];
#pragma unroll
        for (int s = 0; s < 16; ++s) { fa[s] = ldo(pa + (s0 + s) * 512, oa); fb[s] = ldo(pb + (s0 + s) * 512, loff); }
#pragma unroll
        for (int s = 0; s < 16; s += 2) { acc = MFMA32(fa[s], fb[s], acc); acc2 = MFMA32(fa[s + 1], fb[s + 1], acc2); }
    }
    acc = acc + acc2;
    const int tok0 = tt * 32, b = tok0 >> 8, key0 = tok0 & 255, tile = key0 >> 6;
    if (!isv) {
        bf16_t* o = MK + ((size_t)(((b * 8 + hd) * 4 + tile) * 8 + ((key0 >> 5) & 1) * 4 + dt * 2)) * 512;
        sto8(o, poff, acc, 0); sto8(o + 512, poff, acc, 8);
    } else {
        bf16_t* o = MVT + ((size_t)(((b * 8 + hd) * 4 + tile) * 8 + dt * 4 + ((key0 >> 4) & 3))) * 512;
        sto8(o, loff, acc, 0); sto8(o + 512, loff, acc, 8);
    }
}
DI void mem_unit(const bf16_t* __restrict__ Q, const int ldq, const bf16_t* __restrict__ MK, const bf16_t* __restrict__ MVT, bf16_t* __restrict__ O, const int row0, const int hm, const int lay, int lane) {
    asm volatile("" : "+v"(lane));
    const int li = lane & 31, hh = lane >> 5, b = row0 / SEQ;
    const bf16_t* qu = Q + (size_t)row0 * ldq + hm * 64;
    const bf16_t* ku = MK + (size_t)((b * 8 + lay * 4 + hm) * 4) * 4096;
    const bf16_t* vu = MVT + (size_t)((b * 8 + lay * 4 + hm) * 4) * 4096;
    bf16_t* ou = O + (size_t)row0 * 1024 + 768 + hm * 64;
    const unsigned qoff = (unsigned)(li * ldq + hh * 8) * 2u, ooff = (unsigned)(li * 1024 + hh * 8) * 2u, loff = (unsigned)lane * 16u;
    bf16x8 qf[4];
#pragma unroll
    for (int s = 0; s < 4; ++s) qf[s] = ldo(qu, qoff + 32 * s);
    f32x16 o0 = {}, o1 = {}; float mrun = -1e30f, lsum = 0.f;
    bf16x8 kf[2][4], vf[2][4];
#pragma unroll
    for (int hf = 0; hf < 2; ++hf)
#pragma unroll
        for (int s = 0; s < 4; ++s) kf[hf][s] = ldo(ku, loff + (hf * 4 + s) * 1024);
#pragma unroll 1
    for (int c = 0; c < 4; ++c) {
        bf16x8 kn[2][4];
#pragma unroll
        for (int dt = 0; dt < 2; ++dt)
#pragma unroll
            for (int s = 0; s < 4; ++s) vf[dt][s] = ldo(vu + c * 4096, loff + (dt * 4 + s) * 1024);
        { const int cn = c < 3 ? c + 1 : 3;
#pragma unroll
            for (int hf = 0; hf < 2; ++hf)
#pragma unroll
                for (int s = 0; s < 4; ++s) kn[hf][s] = ldo(ku + cn * 4096, loff + (hf * 4 + s) * 1024);
        }
        f32x16 p0 = {}, p1 = {};
#pragma unroll
        for (int s = 0; s < 4; ++s) { p0 = MFMA32(kf[0][s], qf[s], p0); p1 = MFMA32(kf[1][s], qf[s], p1); }
        float mx = __builtin_fmaxf(p0[0], p1[0]);
#pragma unroll
        for (int i = 1; i < 16; ++i) mx = __builtin_fmaxf(mx, __builtin_fmaxf(p0[i], p1[i]));
        float ml, mh; halves(mx, ml, mh); mx = __builtin_fmaxf(ml, mh);
        const float mnew = __builtin_fmaxf(mrun, mx), alpha = __builtin_amdgcn_exp2f(mrun - mnew); mrun = mnew;
        float ps = 0.f;
#pragma unroll
        for (int i = 0; i < 16; ++i) { p0[i] = __builtin_amdgcn_exp2f(p0[i] - mnew); p1[i] = __builtin_amdgcn_exp2f(p1[i] - mnew); ps += p0[i] + p1[i]; }
        lsum = lsum * alpha + ps;
#pragma unroll
        for (int i = 0; i < 16; ++i) { o0[i] *= alpha; o1[i] *= alpha; }
        const bf16x8 w0 = PACK8(p0, 0), w1 = PACK8(p0, 8), w2 = PACK8(p1, 0), w3 = PACK8(p1, 8);
        o0 = MFMA32(vf[0][0], w0, o0); o1 = MFMA32(vf[1][0], w0, o1);
        o0 = MFMA32(vf[0][1], w1, o0); o1 = MFMA32(vf[1][1], w1, o1);
        o0 = MFMA32(vf[0][2], w2, o0); o1 = MFMA32(vf[1][2], w2, o1);
        o0 = MFMA32(vf[0][3], w3, o0); o1 = MFMA32(vf[1][3], w3, o1);
#pragma unroll
        for (int x = 0; x < 2; ++x)
#pragma unroll
            for (int s = 0; s < 4; ++s) kf[x][s] = kn[x][s];
    }
    float ll, lh; halves(lsum, ll, lh); const float inv = 1.0f / (ll + lh);
#pragma unroll
    for (int i = 0; i < 16; ++i) { o0[i] *= inv; o1[i] *= inv; }
    sto8(ou, ooff, o0, 0); sto8(ou, ooff + 32, o0, 8); sto8(ou, ooff + 64, o1, 0); sto8(ou, ooff + 96, o1, 8);
}
template <int GI> DI void pool_unit_t(const bf16_t* __restrict__ U, const bf16_t* __restrict__ WG, bf16_t* __restrict__ O, const int row0, int lane) {
    asm volatile("" : "+v"(lane));
    constexpr int w = 2 << GI;
    const int li = lane & 31, hh = lane >> 5, pos = (row0 & (SEQ - 1)) + li;
    const int cnt = (pos + 1) < w ? (pos + 1) : w; const float rc = 1.0f / (float)cnt;
    const char* ub = (const char*)(U + ((size_t)(row0 >> 5) * 48 + GI * 12) * 512) - 48 * 1024;
    bf16_t* ou = O + (size_t)row0 * 1024 + GI * 192;
    const unsigned ooff = (unsigned)(li * 1024 + hh * 8) * 2u, loff = (unsigned)lane * 16u;
    const float nextra = (float)((w - 1 - pos) > 0 ? (w - 1 - pos) : 0);
    f32x16 o[6];
#pragma unroll
    for (int d = 0; d < 6; ++d) o[d] = f32x16{};
#pragma unroll 1
    for (int s = 0; s < 12; ++s) {
        const u32x4 v0 = *(const u32x4*)(ub + (unsigned)(48 * 1024 + s * 1024) + loff);
        bf16x8 wf[6];
#pragma unroll
        for (int d = 0; d < 6; ++d) wf[d] = ldo(WG, loff + (d * 12 + s) * 1024);
        float cur[8], sum[8], last[8];
#pragma unroll
        for (int e = 0; e < 4; ++e) { cur[2 * e] = __uint_as_float(v0[e] << 16); cur[2 * e + 1] = __uint_as_float(v0[e] & 0xffff0000u); sum[2 * e] = cur[2 * e]; sum[2 * e + 1] = cur[2 * e + 1]; }
#pragma unroll
        for (int i0 = 1; i0 < w; i0 += 8) {
            constexpr int NBATCH = 8;
            u32x4 v[NBATCH];
#pragma unroll
            for (int i = 0; i < NBATCH; ++i) if (i0 + i < w) { const int ie = (i0 + i) < pos ? (i0 + i) : pos, rr = li - ie;
                v[i] = *(const u32x4*)(ub + ((unsigned)(((rr >> 5) + 1) * (48 * 1024) + s * 1024) + (unsigned)(((rr & 31) + 32 * hh) * 16))); }
#pragma unroll
            for (int i = 0; i < NBATCH; ++i) if (i0 + i < w) {
#pragma unroll
                for (int e = 0; e < 4; ++e) { const float lo = __uint_as_float(v[i][e] << 16), hi = __uint_as_float(v[i][e] & 0xffff0000u); sum[2 * e] += lo; sum[2 * e + 1] += hi; if (i0 + i == w - 1) { last[2 * e] = lo; last[2 * e + 1] = hi; } } }
        }
        const bf16x8 pf = pack8((sum[0] - nextra * last[0]) * rc - cur[0], (sum[1] - nextra * last[1]) * rc - cur[1], (sum[2] - nextra * last[2]) * rc - cur[2], (sum[3] - nextra * last[3]) * rc - cur[3],
                                (sum[4] - nextra * last[4]) * rc - cur[4], (sum[5] - nextra * last[5]) * rc - cur[5], (sum[6] - nextra * last[6]) * rc - cur[6], (sum[7] - nextra * last[7]) * rc - cur[7]);
#pragma unroll
        for (int d = 0; d < 6; ++d) o[d] = MFMA32(wf[d], pf, o[d]);
    }
#pragma unroll
    for (int d = 0; d < 6; ++d) { sto8(ou, ooff + d * 64, o[d], 0); sto8(ou, ooff + d * 64 + 32, o[d], 8); }
}
DI void pool_unit(const bf16_t* __restrict__ U, const bf16_t* __restrict__ WG, bf16_t* __restrict__ O, const int row0, const int g, const int lane) {
    if (g == 0) pool_unit_t<0>(U, WG, O, row0, lane); else if (g == 1) pool_unit_t<1>(U, WG, O, row0, lane); else if (g == 2) pool_unit_t<2>(U, WG, O, row0, lane); else pool_unit_t<3>(U, WG, O, row0, lane);
}
}
#define LAS __attribute__((address_space(3)))
typedef unsigned short bf16;
typedef unsigned v4u __attribute__((ext_vector_type(4)));
typedef float f32x4 __attribute__((ext_vector_type(4)));
__device__ __forceinline__ float wave_sum(float v) {
#pragma unroll
    for (int o = 1; o < 64; o <<= 1) v += __shfl_xor(v, o);
    return v;
}
__device__ __forceinline__ void tr_item(const float* __restrict__ W, int N, int k0, int n0, bf16* dst, int Kld, const float* gk, const float* cn, LAS float* scr, int lane, bf16* fragbase = nullptr, int fragkb = 12, int fragrow0 = 0) {
    const int c4 = (lane & 15) * 4, kr = lane >> 4;
    f32x4 cs = {1.f, 1.f, 1.f, 1.f}; if (cn) cs = *(const f32x4*)(cn + n0 + c4);
    const float* wp = W + (size_t)(k0 + kr) * N + n0 + c4;
    f32x4 v[16];
#pragma unroll
    for (int i = 0; i < 16; ++i) v[i] = *(const f32x4*)(wp + (size_t)(4 * i) * N);
#pragma unroll
    for (int i = 0; i < 16; ++i) { const int kk = 4 * i + kr; f32x4 x = v[i] * cs; if (gk) x = x * gk[k0 + kk];
        LAS float* d = scr + kk * 65 + c4; d[0] = x[0]; d[1] = x[1]; d[2] = x[2]; d[3] = x[3]; }
    asm volatile("s_waitcnt lgkmcnt(0)" ::: "memory");
    const int c = lane & 7;
#pragma unroll
    for (int j = 0; j < 8; ++j) { const int n = (lane >> 3) + 8 * j; const LAS float* s = scr + (8 * c) * 65 + n;
        v4u o; o.x = pg8::cvt_pk_bf16(s[0 * 65], s[1 * 65]); o.y = pg8::cvt_pk_bf16(s[2 * 65], s[3 * 65]); o.z = pg8::cvt_pk_bf16(s[4 * 65], s[5 * 65]); o.w = pg8::cvt_pk_bf16(s[6 * 65], s[7 * 65]);
        if (fragbase) { const int ng = fragrow0 + n, kg = k0 + 8 * c, ni = ng & 31, pn = (ni & 0x13) | ((ni & 4) << 1) | ((ni & 8) >> 1);
            *(v4u*)(fragbase + ((size_t)(ng >> 5) * fragkb + (kg >> 4)) * 512 + (pn + 32 * ((kg >> 3) & 1)) * 8) = o; }
        else *(v4u*)(dst + (size_t)n * Kld + 8 * c) = o; }
    asm volatile("s_waitcnt lgkmcnt(0)" ::: "memory");
}
__device__ __forceinline__ int rowmap(int mode, int n0) {
    switch (mode) {
        case 1: return n0 < 256 ? n0 : 512 + (n0 - 256);
        case 2: return n0 < 256 ? 256 + n0 : 768 + (n0 - 256);
        case 3: { const int f = n0 < DFF ? n0 : n0 - DFF; return (f / 128) * 256 + (n0 < DFF ? 0 : 128) + (f % 128); }
        case 4: return n0 < 768 ? n0 : n0 + 1024;
        case 5: return 768 + n0;
        default: return n0;
    }
}
#define XB_TMO      128
#define XB_XCNT(j)  (256  + 64 * (j))
#define XB_XSUB(j)  (1280 + 64 * (j))
#define XB_XGEN(j)  (2304 + 64 * (j))
#define XB_TOP      3328
#define XB_TOPGEN   3392
#define XCD_BAR_WORDS 3456
#define XB_SPIN_CAP (1u << 18)

__device__ __forceinline__ unsigned xb_ld(unsigned* p)              { return __hip_atomic_load(p, __ATOMIC_RELAXED, __HIP_MEMORY_SCOPE_AGENT); }
__device__ __forceinline__ unsigned xb_add(unsigned* p, unsigned v) { return __hip_atomic_fetch_add(p, v, __ATOMIC_RELAXED, __HIP_MEMORY_SCOPE_AGENT); }
__device__ __forceinline__ unsigned xb_xcc_id() { return (unsigned)__builtin_amdgcn_s_getreg((3 << 11) | 20) & 0xFu; }
#define XB_SPIN(cond, bar) do { unsigned _sp = 0; while (cond) { __builtin_amdgcn_s_sleep(1); \
    if ((++_sp & 255u) == 0u) { if (xb_ld(&(bar)[XB_TMO])) break; if (_sp > XB_SPIN_CAP) { atomicAdd(&(bar)[XB_TMO], 1u); break; } } } } while (0)

struct XcdBarrier {
    unsigned* bar; unsigned x;
    volatile LAS unsigned* st;
};

__device__ __forceinline__ XcdBarrier xcd_barrier_post(unsigned* bar, volatile LAS unsigned* st) {
    XcdBarrier b; b.bar = bar; b.x = xb_xcc_id(); b.st = st;
    if (threadIdx.x == 0) (void)xb_add(&bar[XB_XCNT(b.x)], 1u);
    return b;
}
__device__ __forceinline__ void xcd_barrier_complete(unsigned* bar, unsigned x, unsigned& nloc, unsigned& nx) {
    const unsigned G = gridDim.x * gridDim.y * gridDim.z;
    unsigned sum, cnt, mine, sp = 0u;
    for (;;) {
        sum = 0u; cnt = 0u; mine = 0u;
#pragma unroll
        for (unsigned j = 0; j < 16; ++j) { const unsigned c = xb_ld(&bar[XB_XCNT(j)]); sum += c; cnt += (c > 0u) ? 1u : 0u; mine = (j == x) ? c : mine; }
        if (sum == G) break;
        __builtin_amdgcn_s_sleep(1);
        if ((++sp & 255u) == 0u) { if (xb_ld(&bar[XB_TMO])) break; if (sp > XB_SPIN_CAP) { atomicAdd(&bar[XB_TMO], 1u); break; } }
    }
    nloc = mine > 0u ? mine : 1u; nx = cnt > 0u ? cnt : 1u;
}

__device__ __forceinline__ void xcd_barrier(const XcdBarrier& b) {
    asm volatile("s_waitcnt vmcnt(0)" ::: "memory");
    __syncthreads();
    if (threadIdx.x == 0) {
        unsigned* bar = b.bar;
        __builtin_amdgcn_s_waitcnt(0);
        unsigned nloc = b.st[0], nx = b.st[1];
        if (nloc == 0u) { xcd_barrier_complete(bar, b.x, nloc, nx); b.st[0] = nloc; b.st[1] = nx; }
        const unsigned old = xb_add(&bar[XB_XSUB(b.x)], 1u);
        const unsigned gen = old / nloc;
        if (old + 1u == (gen + 1u) * nloc) {
            __builtin_amdgcn_fence(__ATOMIC_RELEASE, "agent");
            asm volatile("s_waitcnt vmcnt(0)" ::: "memory");
            const unsigned og = xb_add(&bar[XB_TOP], 1u);
            const unsigned tg = og / nx;
            if (og + 1u == (tg + 1u) * nx) xb_add(&bar[XB_TOPGEN], 1u);
            else XB_SPIN(xb_ld(&bar[XB_TOPGEN]) == tg, bar);
            __builtin_amdgcn_fence(__ATOMIC_ACQUIRE, "agent");
            xb_add(&bar[XB_XGEN(b.x)], 1u);
            asm volatile("s_waitcnt vmcnt(0)" ::: "memory");
        } else {
            XB_SPIN(xb_ld(&bar[XB_XGEN(b.x)]) == gen, bar);
            __builtin_amdgcn_fence(__ATOMIC_ACQUIRE, "agent");
            asm volatile("s_waitcnt vmcnt(0)" ::: "memory");
        }
    }
    __syncthreads();
}

#ifndef REP_PRO
#define REP_PRO 1
#endif
#ifndef REP_MIXA
#define REP_MIXA 1
#endif
#ifndef REP_MIXB
#define REP_MIXB 1
#endif
#ifndef REP_FIN
#define REP_FIN 1
#endif
#ifndef REP_UP
#define REP_UP 1
#endif
struct Args { const float* in[22]; float* out; unsigned char* ws; };

__global__ void __launch_bounds__(512, 2) yoco_fwd(Args a) {
    extern __shared__ __attribute__((aligned(16))) unsigned char lds_raw[];
    cg::grid_group grid = cg::this_grid();
    LAS unsigned char* lds = (LAS unsigned char*)lds_raw;
    const int tid = threadIdx.x, wave = __builtin_amdgcn_readfirstlane(tid >> 6);
    const int G = gridDim.x, bx = blockIdx.x, vcu = (G % 8 == 0) ? (bx % 8) * (G / 8) + bx / 8 : bx;
    const int gw = vcu * 8 + wave, NGW = G * 8;
    volatile LAS unsigned* MISC = (volatile LAS unsigned*)(lds + 134144);
    if (tid < 16) MISC[tid] = 0u;
    __syncthreads();
    const XcdBarrier xbar = xcd_barrier_post((unsigned*)a.ws, MISC + 8);
    if (a.out == nullptr) grid.sync();
#define GSYNC() xcd_barrier(xbar)
#define WSP(T_, off) ((T_*)(a.ws + (off)))
#define W_AIN WSP(bf16, WS_W_AIN)
#define W_AOUT WSP(bf16, WS_W_AOUT)
#define W_AGU WSP(bf16, WS_W_AGU)
#define W_ADOWN WSP(bf16, WS_W_ADOWN)
#define W_MKV WSP(bf16, WS_W_MKV)
#define W_KQV WSP(bf16, WS_W_KQV)
#define W_BOUT WSP(bf16, WS_W_BOUT)
#define W_BGU WSP(bf16, WS_W_BGU)
#define W_BDOWN WSP(bf16, WS_W_BDOWN)
#define W_GRP WSP(bf16, WS_W_GRP)
#define MEMN WSP(bf16, WS_MEMN)
#define MEMK WSP(bf16, WS_MEMK)
#define MEMVT WSP(bf16, WS_MEMVT)
#define SS WSP(float, WS_SS)
#define XB WSP(bf16, WS_XB)
#define PROJ WSP(bf16, WS_PROJ)
#define MIX WSP(bf16, WS_MIX)
#define QMA (PROJ + (size_t)T * 768)
#define KB WSP(bf16, WS_KB)
#define VT WSP(bf16, WS_VT)
#define HB WSP(bf16, WS_H)
#define GEMM_SCALE(gA, gB, gM, gN, gK, e0, e1, ld0, ld1, csplit, sc1, rss, css, vtb) do { pg8::Gemm g{gA, gB, gM, gN, gK}; pg8::StaticOrder S; S.init(gM, gN, G, bx); \
        pg8::EpiScale E{e0, e1, rss, css, ld0, ld1, csplit, sc1, vtb, 12, 12}; pg8::gemm_phase<pg8::EpiScale, pg8::StaticOrder, true, true>(lds, g, S, E); } while (0)
#define GEMM_SWIGLU(gA, gB, rss) do { pg8::Gemm g{gA, gB, T, 2 * DFF, 1024}; pg8::StaticOrder S; S.init(T, 2 * DFF, G, bx); \
        pg8::EpiSwiglu E{HB, rss, DFF}; pg8::gemm_phase<pg8::EpiSwiglu, pg8::StaticOrder, true, true>(lds, g, S, E); } while (0)
#define GEMM_RESID(F32B, gA, gB, gK, rbase, ssout) do { pg8::Gemm g{gA, gB, T, 1024, gK}; pg8::StaticOrder S; S.init(T, 1024, G, bx); \
        pg8::EpiResid<F32B> E{rbase, XB, ssout}; pg8::gemm_phase<pg8::EpiResid<F32B>, pg8::StaticOrder, true, true>(lds, g, S, E); } while (0)
#if REP_PRO > 1
    for (int rep = 0; rep < REP_PRO; ++rep)
#endif
    {
            int lane; asm volatile("v_mbcnt_lo_u32_b32 %0, -1, 0\n\tv_mbcnt_hi_u32_b32 %0, -1, %0" : "=v"(lane));
            LAS float* scr = (LAS float*)(lds + wave * 16640);
            constexpr int NITEMS = 256 + 36 + 2 * 128 + 2 * 256 + 2 * 1408 + 2 * 704 + 384 + 256;
            for (int it = gw; it < NITEMS; it += NGW) {
                int r = it; const float* W; const float* gk = nullptr; const float* cn = nullptr; bf16* WT; bf16* frag = nullptr; int fragkb = 12; int K = 1024, N = 1024, mode = 0;
                if (r < 256) { W = a.in[4]; gk = a.in[3]; WT = W_AIN; }
                else if ((r -= 256) < 36) { const int gi = r / 9; r -= gi * 9; W = a.in[5] + gi * 36864; cn = a.in[6] + gi * 192; WT = W_GRP + gi * 36864; frag = WT; K = 192; N = 192; }
                else if ((r -= 36) < 128) { W = a.in[7]; gk = a.in[2]; WT = W_MKV; frag = W_MKV; fragkb = 64; N = 512; mode = 1; }
                else if ((r -= 128) < 128) { W = a.in[16]; gk = a.in[2]; WT = W_MKV; frag = W_MKV; fragkb = 64; N = 512; mode = 2; }
                else if ((r -= 128) < 256) { W = a.in[8]; WT = W_AOUT; }
                else if ((r -= 256) < 256) { W = a.in[17]; WT = W_BOUT; }
                else if ((r -= 256) < 1408) { W = a.in[10]; gk = a.in[9]; WT = W_AGU; N = 2 * DFF; mode = 3; }
                else if ((r -= 1408) < 1408) { W = a.in[19]; gk = a.in[18]; WT = W_BGU; N = 2 * DFF; mode = 3; }
                else if ((r -= 1408) < 704) { W = a.in[11]; WT = W_ADOWN; K = DFF; }
                else if ((r -= 704) < 704) { W = a.in[20]; WT = W_BDOWN; K = DFF; }
                else if ((r -= 704) < 384) { W = a.in[13]; gk = a.in[12]; WT = W_KQV; N = 1536; mode = 4; }
                else { r -= 384; W = a.in[15]; gk = a.in[14]; WT = W_KQV; mode = 5; }
                const int nblk = N / 64, k0 = 64 * (r / nblk), n0 = 64 * (r % nblk);
                tr_item(W, N, k0, n0, WT + (size_t)rowmap(mode, n0) * K + k0, K, gk, cn, scr, lane, frag, fragkb, frag == W_MKV ? rowmap(mode, n0) : n0);
            }
            for (int q = gw; q < (T + MROWS) / 4; q += NGW) {
                const int m0 = q * 4; const bool ismem = m0 >= T; const float* src = ismem ? a.in[1] + (size_t)(m0 - T) * DM : a.in[0] + (size_t)m0 * DM;
                const f32x4* xr = (const f32x4*)src + lane; f32x4 v[4][4]; float s[4];
#pragma unroll
                for (int r = 0; r < 4; ++r)
#pragma unroll
                    for (int j = 0; j < 4; ++j) v[r][j] = xr[r * 256 + 64 * j];
#pragma unroll
                for (int r = 0; r < 4; ++r) { s[r] = 0.f;
#pragma unroll
                    for (int j = 0; j < 4; ++j) s[r] += (v[r][j].x * v[r][j].x + v[r][j].y * v[r][j].y) + (v[r][j].z * v[r][j].z + v[r][j].w * v[r][j].w); }
#pragma unroll
                for (int o = 1; o < 64; o <<= 1) { s[0] += __shfl_xor(s[0], o); s[1] += __shfl_xor(s[1], o); s[2] += __shfl_xor(s[2], o); s[3] += __shfl_xor(s[3], o); }
                if (!ismem && lane < 4) SS[m0 + lane] = lane == 0 ? s[0] : lane == 1 ? s[1] : lane == 2 ? s[2] : s[3];
                unsigned long long* o8 = (unsigned long long*)(XB + (size_t)m0 * DM) + lane;
#pragma unroll
                for (int r = 0; r < 4; ++r) { const float sc = ismem ? pg8::rstd_of(s[r]) : 1.f;
#pragma unroll
                    for (int j = 0; j < 4; ++j) { const unsigned long long pk = (unsigned long long)pg8::cvt_pk_bf16(v[r][j].x * sc, v[r][j].y * sc) | ((unsigned long long)pg8::cvt_pk_bf16(v[r][j].z * sc, v[r][j].w * sc) << 32);
                        if (ismem) { const int row = m0 - T + r, k = 4 * (64 * j + lane);
                            *(unsigned long long*)(MEMN + ((size_t)(row >> 5) * 64 + (k >> 4)) * 512 + ((row & 31) + 32 * ((k >> 3) & 1)) * 8 + (k & 7)) = pk; }
                        else o8[r * 256 + 64 * j] = pk; } }
            }
            for (int i = gw * 64 + lane; i < 4 * T; i += NGW * 64) __hip_atomic_store(SS + T + i, 0.f, __ATOMIC_RELAXED, __HIP_MEMORY_SCOPE_AGENT);
    }
    GSYNC();
    GEMM_SCALE(XB, W_AIN, T, 1024, 1024, PROJ, QMA, 1024, 256, 768, C2, SS, (const float*)nullptr, 3);
    {
        int lane; asm volatile("v_mbcnt_lo_u32_b32 %0, -1, 0\n\tv_mbcnt_hi_u32_b32 %0, -1, %0" : "=v"(lane));
        for (int u = gw; u < 2048; u += NGW) mix::memkv_unit(MEMN, W_MKV, MEMK, MEMVT, u, lane);
    }
    GSYNC();
#if REP_MIXA > 1
    for (int rep = 0; rep < REP_MIXA; ++rep)
#endif
    {
            int lane; asm volatile("v_mbcnt_lo_u32_b32 %0, -1, 0\n\tv_mbcnt_hi_u32_b32 %0, -1, %0" : "=v"(lane));
            for (int i = 0; i < 2; ++i) { const int u = gw + NGW * i; if (u < 4096) mix::pool_unit(PROJ, W_GRP + (size_t)((u & 3) ^ (i ? 3 : 0)) * 36864, MIX, (u >> 2) * 32, (u & 3) ^ (i ? 3 : 0), lane); }
            for (int u = gw; u < 4096; u += NGW) mix::mem_unit(QMA, 256, MEMK, MEMVT, MIX, (u >> 2) * 32, u & 3, 0, lane);
    }
    GSYNC();
    GEMM_RESID(true, MIX, W_AOUT, 1024, a.in[0], SS + T);
    GSYNC();
#if REP_UP > 1
    for (int rep = 0; rep < REP_UP; ++rep)
#endif
    GEMM_SWIGLU(XB, W_AGU, SS + T);
    GSYNC();
    GEMM_RESID(false, HB, W_ADOWN, DFF, (const float*)nullptr, SS + 2 * T);
    GSYNC();
    {
        static_assert(WS_XB - WS_W_KQV == (size_t)pg8::KqvOrder::XT0 * 256 * 1024 * 2, "XB tile index relative to W_KQV");
        pg8::Gemm g{W_KQV, W_KQV, 0, 0, 1024}; pg8::KqvOrder S; S.init(G, bx);
        pg8::EpiKqv E{KB, PROJ, VT, SS + 2 * T}; pg8::gemm_phase<pg8::EpiKqv, pg8::KqvOrder, true, true>(lds, g, S, E);
    }
    GSYNC();
#if REP_MIXB > 1
    for (int rep = 0; rep < REP_MIXB; ++rep)
#endif
    {
            int lane; asm volatile("v_mbcnt_lo_u32_b32 %0, -1, 0\n\tv_mbcnt_hi_u32_b32 %0, -1, %0" : "=v"(lane));
            int i = 0;
            for (int u = gw; u < NB * 12 * 128; u += NGW, ++i) { const int bh = u >> 7; int qb = u & 127; if (i & 1) qb = 127 - qb; mix::sb_unit(PROJ, KB, VT, MIX, bh / 12, bh % 12, qb * 32, lane); }
            for (int u = gw; u < 4096; u += NGW) mix::mem_unit(PROJ + 768, 1024, MEMK, MEMVT, MIX, (u >> 2) * 32, u & 3, 1, lane);
    }
    GSYNC();
    GEMM_RESID(false, MIX, W_BOUT, 1024, (const float*)nullptr, SS + 3 * T);
    GSYNC();
    GEMM_SWIGLU(XB, W_BGU, SS + 3 * T);
    GSYNC();
    GEMM_RESID(false, HB, W_BDOWN, DFF, (const float*)nullptr, SS + 4 * T);
    GSYNC();
#if REP_FIN > 1
    for (int rep = 0; rep < REP_FIN; ++rep)
#endif
    {
            int lane; asm volatile("v_mbcnt_lo_u32_b32 %0, -1, 0\n\tv_mbcnt_hi_u32_b32 %0, -1, %0" : "=v"(lane));
            const f32x4* gr = (const f32x4*)a.in[21] + lane; f32x4 gv[4];
#pragma unroll
            for (int j = 0; j < 4; ++j) gv[j] = gr[64 * j];
            for (int q = gw; q < T / 4; q += NGW) { const int m0 = q * 4;
                const f32x4 ss4 = *(const f32x4*)(SS + 4 * T + m0);
                const unsigned long long* xh = (const unsigned long long*)(XB + (size_t)m0 * DM) + lane;
                f32x4* orow = (f32x4*)(a.out + (size_t)m0 * DM) + lane; unsigned long long vh[4][4];
#pragma unroll
                for (int r = 0; r < 4; ++r)
#pragma unroll
                    for (int j = 0; j < 4; ++j) vh[r][j] = xh[r * 256 + 64 * j];
#pragma unroll
                for (int r = 0; r < 4; ++r) { const float rs = pg8::rstd_of(ss4[r]);
#pragma unroll
                    for (int j = 0; j < 4; ++j) { const unsigned h0 = (unsigned)vh[r][j], h1 = (unsigned)(vh[r][j] >> 32);
                        const f32x4 v = {__uint_as_float(h0 << 16), __uint_as_float(h0 & 0xffff0000u), __uint_as_float(h1 << 16), __uint_as_float(h1 & 0xffff0000u)};
                        __builtin_nontemporal_store(v * gv[j] * rs, orow + r * 256 + 64 * j); } } }
    }
}

extern "C" void kernel_launch(void* const* d_in, const int* in_sizes, int n_in, void* d_out, int out_size, void* d_ws, size_t ws_size, hipStream_t stream) {
    constexpr int LDS_BYTES = 135168;
    static int grid = 0;
    if (grid == 0) {
        if (n_in != 22 || ws_size < WS_END) { fprintf(stderr, "kernel_launch: unexpected inputs (n_in %d, ws %zu)\n", n_in, ws_size); grid = -1; return; }
        int dev = 0, cus = 0, per_cu = 0;
        hipGetDevice(&dev); hipDeviceGetAttribute(&cus, hipDeviceAttributeMultiprocessorCount, dev);
        if (hipFuncSetAttribute((const void*)yoco_fwd, hipFuncAttributeMaxDynamicSharedMemorySize, LDS_BYTES) != hipSuccess) { fprintf(stderr, "kernel_launch: hipFuncSetAttribute failed\n"); }
        if (hipOccupancyMaxActiveBlocksPerMultiprocessor(&per_cu, (const void*)yoco_fwd, 512, LDS_BYTES) != hipSuccess || per_cu < 1) { fprintf(stderr, "kernel_launch: occupancy query says %d\n", per_cu); per_cu = 1; }
        (void)hipGetLastError();
        grid = cus;
    }
    if (grid < 0) return;
    if (hipMemsetAsync(d_ws, 0, 16384, stream) != hipSuccess) { fprintf(stderr, "kernel_launch: memset failed\n"); return; }
    Args a{};
    for (int i = 0; i < 22; ++i) a.in[i] = (const float*)d_in[i];
    a.out = (float*)d_out; a.ws = (unsigned char*)d_ws;
    void* args[] = {&a};
    hipError_t e = hipLaunchCooperativeKernel((const void*)yoco_fwd, dim3(grid), dim3(512), args, LDS_BYTES, stream);
    if (e != hipSuccess) fprintf(stderr, "cooperative launch failed: %s (grid %d)\n", hipGetErrorString(e), grid);
}
```

```cpp
#include <hip/hip_runtime.h>
#include <hip/hip_cooperative_groups.h>
#include <cstdio>
#include <cstdint>
namespace cg = cooperative_groups;
namespace pg8 {
#define PG8_LAS __attribute__((address_space(3)))
typedef unsigned short bf16_t;
typedef short bf16x8 __attribute__((ext_vector_type(8)));
typedef float f32x4 __attribute__((ext_vector_type(4)));
typedef unsigned u32x4 __attribute__((ext_vector_type(4)));
constexpr int BM = 256, BK = 64, HALF = 128, HTB = HALF * BK * 2  , STAGE_BYTES = 8 * HTB, NXCD = 8, WGM = 8;

__host__ __device__ __forceinline__ int lds_byte(int r, int c) { const int st = (r >> 4) * 2 + (c >> 5), rr = r & 15, cc = c & 31, ob = rr * 64 + cc * 2; return st * 1024 + (ob ^ (((ob >> 9) & 1) << 5)); }
__host__ __device__ __forceinline__ void stage_rc(int b, int& R, int& C) { const int st = b / 1024, sb = b % 1024, swz = sb ^ (((sb >> 9) & 1) << 5); R = (st >> 1) * 16 + swz / 64; C = (st & 1) * 32 + (swz % 64) / 2; }
__host__ __device__ __forceinline__ int perm32(int rho) { const int n = rho >> 4, i = rho & 15; return 8 * (i >> 2) + 4 * n + (i & 3); }

struct Unit { int pm, pn; };
struct Gemm { const bf16_t* A; const bf16_t* Bt; int M, N, K; };

struct StaticOrder {
    int nM, nN, nwg, G, c;
    __host__ __device__ void init(int M, int N, int G_, int c_) { nM = M / BM; nN = N / BM; nwg = nM * nN; G = G_; c = c_; }
    __host__ __device__ bool next(int i, Unit& u) const { return at((long)i * G + c, u); }
    __host__ __device__ bool at(const long L, Unit& u) const {
        if (L >= nwg) return false;
        int wgid = (int)L; { const int q = nwg / NXCD, r = nwg % NXCD, xcd = wgid % NXCD, off = wgid / NXCD; wgid = (xcd < r ? xcd * (q + 1) : r * (q + 1) + (xcd - r) * q) + off; }
        const int nig = WGM * nN, gid = wgid / nig, fm = gid * WGM, gsz = (nM - fm) < WGM ? (nM - fm) : WGM;
        u.pm = fm + ((wgid % nig) % gsz); u.pn = (wgid % nig) / gsz; return true;
    }
    __device__ __forceinline__ void a_ready(const Unit&) const {}
    __device__ __forceinline__ void done(const Unit&) const {}
};
typedef float f32x2 __attribute__((ext_vector_type(2)));
typedef __bf16 bf16x2_t __attribute__((ext_vector_type(2)));
__device__ __forceinline__ unsigned cvt_pk_bf16(float lo, float hi) { f32x2 v = {lo, hi}; bf16x2_t b = __builtin_convertvector(v, bf16x2_t); return __builtin_bit_cast(unsigned, b); }
__device__ __forceinline__ float rstd_of(float ss) { return __builtin_amdgcn_rsqf(ss * (1.0f / 1024.0f) + 1e-6f); }

struct EpiScale {
    static constexpr bool PERM = true, AFTER_DRAIN = false;
    bf16_t* O0; bf16_t* O1; const float* rss; const float* css; int ld0, ld1, csplit; float sc1; int vtb, fseq, fnh;
    __device__ __forceinline__ void operator()(const f32x4 (&acc)[2][2][4][2], const Unit& u, int wr, int wc, int fr, int fq) const {
        int colt = u.pn * BM; bf16_t* base = O0; int ld = ld0; float sc = 1.f;
        if (colt >= csplit) { base = O1; ld = ld1; colt -= csplit; sc = sc1; }
        const int col0 = colt + wc * 32 + 8 * fq, gcol0 = u.pn * BM + wc * 32 + 8 * fq;
        const int row0 = u.pm * BM + wr * 64 + fr;
        f32x4 cs[2][2];
#pragma unroll
        for (int bj = 0; bj < 2; ++bj)
#pragma unroll
            for (int n = 0; n < 2; ++n) {
                if (css) { const f32x4 s = *(const f32x4*)(css + gcol0 + bj * HALF + 4 * n); cs[bj][n] = (f32x4){rstd_of(s[0]) * sc, rstd_of(s[1]) * sc, rstd_of(s[2]) * sc, rstd_of(s[3]) * sc}; }
                else cs[bj][n] = (f32x4){sc, sc, sc, sc};
            }
        float rsv[2][4];
#pragma unroll
        for (int ai = 0; ai < 2; ++ai)
#pragma unroll
            for (int m = 0; m < 4; ++m) rsv[ai][m] = rss ? rss[row0 + ai * HALF + m * 16] : 0.f;
#pragma unroll
        for (int ai = 0; ai < 2; ++ai)
#pragma unroll
            for (int m = 0; m < 4; ++m) rsv[ai][m] = rss ? rstd_of(rsv[ai][m]) : 1.f;
#pragma unroll
        for (int ai = 0; ai < 2; ++ai)
#pragma unroll
            for (int m = 0; m < 4; ++m) { const int row = row0 + ai * HALF + m * 16; const float rs = rsv[ai][m];
                bf16_t* rowp = base + (size_t)row * ld + col0;
                if (vtb == 1) { const int hd = row >> 6, d = row & 63, bq = col0 >> fseq, pos = col0 & ((1 << fseq) - 1), di = d & 31, pd = (di & 0x13) | ((di & 4) << 1) | ((di & 8) >> 1);
                    rowp = base + ((size_t)(((bq * fnh + hd) << (fseq - 6)) + (pos >> 6)) * 8 + (d >> 5) * 4 + ((pos >> 4) & 3)) * 512 + (pd + 32 * ((pos >> 3) & 1)) * 8; }
                else if (vtb == 2 && base == O0) { const int bq = row >> fseq, pos = row & ((1 << fseq) - 1), hd = col0 >> 6, d = col0 & 63, ki = pos & 31, pk = (ki & 0x13) | ((ki & 4) << 1) | ((ki & 8) >> 1);
                    rowp = base + ((size_t)(((bq * fnh + hd) << (fseq - 6)) + (pos >> 6)) * 8 + ((pos >> 5) & 1) * 4 + (d >> 4)) * 512 + (pk + 32 * ((d >> 3) & 1)) * 8; }
                else if (vtb == 3 && base == O0) rowp = base + ((size_t)(row >> 5) * 48 + (col0 >> 4)) * 512 + ((row & 31) + 32 * ((col0 >> 3) & 1)) * 8;
#pragma unroll
                for (int bj = 0; bj < 2; ++bj) { const f32x4 v0 = acc[ai][bj][m][0] * cs[bj][0] * rs, v1 = acc[ai][bj][m][1] * cs[bj][1] * rs;
                    u32x4 w; w.x = cvt_pk_bf16(v0[0], v0[1]); w.y = cvt_pk_bf16(v0[2], v0[3]); w.z = cvt_pk_bf16(v1[0], v1[1]); w.w = cvt_pk_bf16(v1[2], v1[3]);
                    *(u32x4*)(rowp + (vtb == 1 ? bj * 2 * 4096 : (vtb == 2 && base == O0) ? bj * ((2 * 64) << fseq) : (vtb == 3 && base == O0) ? bj * 8 * 512 : bj * HALF)) = w; } }
    }
};
struct KqvOrder {
    static constexpr int XT0 = 336, N1 = 896, N2 = 384;
    StaticOrder s1, s2; int G, c;
    __device__ void init(int G_, int c_) { G = G_; c = c_; s1.init(32768, 1792, G_, c_); s2.init(768, 32768, G_, c_); }
    __device__ bool next(int i, Unit& u) const {
        const long L = (long)i * G + c;
        if (L < N1) { s1.at(L, u); u.pm += XT0; return true; }
        if (L < N1 + N2) { s2.at(L - N1, u); u.pm += 7; u.pn += XT0; return true; }
        return false;
    }
    __device__ __forceinline__ void a_ready(const Unit&) const {}
    __device__ __forceinline__ void done(const Unit&) const {}
};
struct EpiKqv {
    static constexpr bool PERM = true, AFTER_DRAIN = false;
    bf16_t* KBp; bf16_t* PROJp; bf16_t* VTp; const float* ss;
    __device__ __forceinline__ void operator()(const f32x4 (&acc)[2][2][4][2], const Unit& u, int wr, int wc, int fr, int fq) const {
        if (u.pm >= KqvOrder::XT0) { const EpiScale E{KBp, PROJp, ss, nullptr, 768, 1024, 768, 0.125f * 1.4426950408889634f, 2, 12, 12}; const Unit v{u.pm - KqvOrder::XT0, u.pn}; E(acc, v, wr, wc, fr, fq); }
        else { const EpiScale E{VTp, VTp, nullptr, ss, 32768, 32768, 1 << 30, 1.f, 1, 12, 12}; const Unit v{u.pm - 7, u.pn - KqvOrder::XT0}; E(acc, v, wr, wc, fr, fq); }
    }
};

__device__ __forceinline__ f32x2 swiglu_pk(f32x2 a, f32x2 b, float nrs, float rs2) {
    const f32x2 t = a * nrs;
    f32x2 ex; ex.x = __builtin_amdgcn_exp2f(t.x); ex.y = __builtin_amdgcn_exp2f(t.y);
    const f32x2 d = ex + 1.0f;
    f32x2 r; r.x = __builtin_amdgcn_rcpf(d.x); r.y = __builtin_amdgcn_rcpf(d.y);
    return ((a * b) * rs2) * r;
}
struct EpiSwiglu {
    static constexpr bool PERM = true, AFTER_DRAIN = false;
    bf16_t* H; const float* rss; int ldh;
    __device__ __forceinline__ void operator()(const f32x4 (&acc)[2][2][4][2], const Unit& u, int wr, int wc, int fr, int fq) const {
        const int col0 = u.pn * HALF + wc * 32 + 8 * fq, row0 = u.pm * BM + wr * 64 + fr;
        float rsv[2][4];
#pragma unroll
        for (int ai = 0; ai < 2; ++ai)
#pragma unroll
            for (int m = 0; m < 4; ++m) rsv[ai][m] = rss[row0 + ai * HALF + m * 16];
#pragma unroll
        for (int ai = 0; ai < 2; ++ai)
#pragma unroll
            for (int m = 0; m < 4; ++m) { const int row = row0 + ai * HALF + m * 16; const float rs = rstd_of(rsv[ai][m]), nrs = rs * -1.4426950408889634f, rs2 = rs * rs;
                const f32x4 g0 = acc[ai][0][m][0], g1 = acc[ai][0][m][1], u0 = acc[ai][1][m][0], u1 = acc[ai][1][m][1];
                const f32x2 h0 = swiglu_pk((f32x2){g0[0], g0[1]}, (f32x2){u0[0], u0[1]}, nrs, rs2), h1 = swiglu_pk((f32x2){g0[2], g0[3]}, (f32x2){u0[2], u0[3]}, nrs, rs2),
                            h2 = swiglu_pk((f32x2){g1[0], g1[1]}, (f32x2){u1[0], u1[1]}, nrs, rs2), h3 = swiglu_pk((f32x2){g1[2], g1[3]}, (f32x2){u1[2], u1[3]}, nrs, rs2);
                u32x4 w; w.x = cvt_pk_bf16(h0.x, h0.y); w.y = cvt_pk_bf16(h1.x, h1.y); w.z = cvt_pk_bf16(h2.x, h2.y); w.w = cvt_pk_bf16(h3.x, h3.y);
                __builtin_nontemporal_store(w, (u32x4*)(H + (size_t)row * ldh + col0)); }
    }
};
__device__ __forceinline__ f32x4 bf_lo4(const u32x4& h, int half) { const unsigned a = half ? h.z : h.x, b = half ? h.w : h.y;
    return (f32x4){__uint_as_float(a << 16), __uint_as_float(a & 0xffff0000u), __uint_as_float(b << 16), __uint_as_float(b & 0xffff0000u)}; }
template <bool F32BASE> struct EpiResid {
    static constexpr bool PERM = true, AFTER_DRAIN = false;
    const float* base; bf16_t* XH; float* ss;
    __device__ __forceinline__ void operator()(const f32x4 (&acc)[2][2][4][2], const Unit& u, int wr, int wc, int fr, int fq) const {
        unsigned off0 = (unsigned)((u.pm * BM + wr * 64 + fr) * 1024 + u.pn * BM + wc * 32 + 8 * fq);
        asm volatile("" : "+v"(off0));
        if constexpr (F32BASE) {
#pragma unroll
            for (int ai = 0; ai < 2; ++ai) {
                f32x4 pre[4][2][2]; u32x4 w[4][2]; float sq[4];
#pragma unroll
                for (int m = 0; m < 4; ++m)
#pragma unroll
                    for (int bj = 0; bj < 2; ++bj) { const unsigned off = off0 + (unsigned)((ai * HALF + m * 16) * 1024 + bj * HALF);
                        pre[m][bj][0] = *(const f32x4*)(base + off); pre[m][bj][1] = *(const f32x4*)(base + off + 4); }
#pragma unroll
                for (int m = 0; m < 4; ++m) { float s = 0.f;
#pragma unroll
                    for (int bj = 0; bj < 2; ++bj) { const f32x4 v0 = pre[m][bj][0] + acc[ai][bj][m][0], v1 = pre[m][bj][1] + acc[ai][bj][m][1];
                        w[m][bj].x = cvt_pk_bf16(v0[0], v0[1]); w[m][bj].y = cvt_pk_bf16(v0[2], v0[3]); w[m][bj].z = cvt_pk_bf16(v1[0], v1[1]); w[m][bj].w = cvt_pk_bf16(v1[2], v1[3]);
                        s += (v0[0] * v0[0] + v0[1] * v0[1]) + (v0[2] * v0[2] + v0[3] * v0[3]) + (v1[0] * v1[0] + v1[1] * v1[1]) + (v1[2] * v1[2] + v1[3] * v1[3]); }
                    s += __shfl_xor(s, 16); s += __shfl_xor(s, 32); sq[m] = s; }
                __builtin_amdgcn_sched_barrier(0);
#pragma unroll
                for (int m = 0; m < 4; ++m) {
#pragma unroll
                    for (int bj = 0; bj < 2; ++bj) *(u32x4*)(XH + off0 + (unsigned)((ai * HALF + m * 16) * 1024 + bj * HALF)) = w[m][bj];
                    if (fq == 0) __hip_atomic_fetch_add(ss + (off0 >> 10) + ai * HALF + m * 16, sq[m], __ATOMIC_RELAXED, __HIP_MEMORY_SCOPE_AGENT); }
                __builtin_amdgcn_sched_barrier(0);
            }
        } else {
            u32x4 pre[2][4][2]; float sq[2][4];
#pragma unroll
            for (int ai = 0; ai < 2; ++ai)
#pragma unroll
                for (int m = 0; m < 4; ++m)
#pragma unroll
                    for (int bj = 0; bj < 2; ++bj) pre[ai][m][bj] = *(const u32x4*)(XH + off0 + (unsigned)((ai * HALF + m * 16) * 1024 + bj * HALF));
#pragma unroll
            for (int ai = 0; ai < 2; ++ai)
#pragma unroll
                for (int m = 0; m < 4; ++m) { float s = 0.f;
#pragma unroll
                    for (int bj = 0; bj < 2; ++bj) { const f32x4 v0 = bf_lo4(pre[ai][m][bj], 0) + acc[ai][bj][m][0], v1 = bf_lo4(pre[ai][m][bj], 1) + acc[ai][bj][m][1];
                        u32x4 w; w.x = cvt_pk_bf16(v0[0], v0[1]); w.y = cvt_pk_bf16(v0[2], v0[3]); w.z = cvt_pk_bf16(v1[0], v1[1]); w.w = cvt_pk_bf16(v1[2], v1[3]); pre[ai][m][bj] = w;
                        s += (v0[0] * v0[0] + v0[1] * v0[1]) + (v0[2] * v0[2] + v0[3] * v0[3]) + (v1[0] * v1[0] + v1[1] * v1[1]) + (v1[2] * v1[2] + v1[3] * v1[3]); }
                    s += __shfl_xor(s, 16); s += __shfl_xor(s, 32); sq[ai][m] = s; }
            __builtin_amdgcn_sched_barrier(0);
#pragma unroll
            for (int ai = 0; ai < 2; ++ai)
#pragma unroll
                for (int m = 0; m < 4; ++m) {
#pragma unroll
                    for (int bj = 0; bj < 2; ++bj) *(u32x4*)(XH + off0 + (unsigned)((ai * HALF + m * 16) * 1024 + bj * HALF)) = pre[ai][m][bj];
                    if (fq == 0) __hip_atomic_fetch_add(ss + (off0 >> 10) + ai * HALF + m * 16, sq[ai][m], __ATOMIC_RELAXED, __HIP_MEMORY_SCOPE_AGENT); }
        }
    }
};

template <class Epi, class Sched, bool ALIGN_EPI = false, bool SP2 = false>
__device__ __forceinline__ void gemm_phase(PG8_LAS unsigned char* lds, const Gemm g, const Sched& S, const Epi& E) {
    int tid_ = threadIdx.x; asm volatile("" : "+v"(tid_));
    const int tid = tid_, wid = __builtin_amdgcn_readfirstlane(tid >> 6), lane = tid & 63, wr = wid >> 2, wc = wid & 3, fr = lane & 15, fq = lane >> 4;
    const int K = g.K, nt = K / BK;
    unsigned voffA[2], voffB[2];
#pragma unroll
    for (int i = 0; i < 2; ++i) { int R, C; stage_rc(tid * 16 + i * 8192, R, C); const int Rb = Epi::PERM ? ((R & ~31) + perm32(R & 31)) : R;
        voffA[i] = (unsigned)(R * K + C) * 2u; voffB[i] = (unsigned)(Rb * K + C) * 2u; }
    const size_t kstep = (size_t)(BK * 2);
    const size_t hstep = (size_t)HALF * K * 2;
    const size_t tstep = 2 * hstep;
    const unsigned ldsw = (unsigned)wid * 1024u;
    const int aoff = lds_byte(wr * 64 + fr, fq * 8), boff = lds_byte(wc * 32 + fr, fq * 8);
#define PG8_SA(b, h) (((b) * 2 + (h)) * HTB)
#define PG8_SB(b, h) ((4 + (b) * 2 + (h)) * HTB)
#define PG8_STAGE(bufoff, gbase, voff) do { _Pragma("unroll") for (int _i = 0; _i < 2; ++_i) \
        __builtin_amdgcn_global_load_lds((const unsigned*)((const char*)(gbase) + (voff)[_i]), (PG8_LAS unsigned*)(lds + (bufoff) + ldsw + _i * 8192), 16, 0, 0); } while (0)
#define PG8_LDA(dst, b, h) do { _Pragma("unroll") for (int m = 0; m < 4; ++m) _Pragma("unroll") for (int k = 0; k < 2; ++k) dst[m][k] = *(const PG8_LAS bf16x8*)(lds + PG8_SA(b, h) + aoff + m * 2048 + k * 1024); } while (0)
#define PG8_LDB(dst, b, h) do { _Pragma("unroll") for (int n = 0; n < 2; ++n) _Pragma("unroll") for (int k = 0; k < 2; ++k) dst[n][k] = *(const PG8_LAS bf16x8*)(lds + PG8_SB(b, h) + boff + n * 2048 + k * 1024); } while (0)
#define PG8_MMA(ai, bj, At, Bt) do { __builtin_amdgcn_s_setprio(1); _Pragma("unroll") for (int m = 0; m < 4; ++m) _Pragma("unroll") for (int n = 0; n < 2; ++n) _Pragma("unroll") for (int k = 0; k < 2; ++k) \
        acc[ai][bj][m][n] = __builtin_amdgcn_mfma_f32_16x16x32_bf16(Bt[n][k], At[m][k], acc[ai][bj][m][n], 0, 0, 0); __builtin_amdgcn_s_setprio(0); } while (0)
#define PG8_WAIT_V(n) asm volatile("s_waitcnt vmcnt(" #n ")" ::: "memory")
#define PG8_WAIT_L(n) asm volatile("s_waitcnt lgkmcnt(" #n ")" ::: "memory")
#define PG8_BAR __builtin_amdgcn_s_barrier()
#define PG8_SCHED __builtin_amdgcn_sched_barrier(0)
    Unit cur, nxt; int ui = 0;
    if (!S.next(0, cur)) return;
    f32x4 acc[2][2][4][2];
#pragma unroll
    for (int a = 0; a < 2; ++a)
#pragma unroll
        for (int b = 0; b < 2; ++b)
#pragma unroll
            for (int m = 0; m < 4; ++m)
#pragma unroll
                for (int n = 0; n < 2; ++n) acc[a][b][m][n] = (f32x4){0.f, 0.f, 0.f, 0.f};
    bf16x8 At[4][2], B0[2][2], B1[2][2];
    const char* cA = (const char*)g.A + (size_t)cur.pm * tstep; const char* cB = (const char*)g.Bt + (size_t)cur.pn * tstep;
    S.a_ready(cur);
    if constexpr (SP2) {
        PG8_STAGE(PG8_SB(0, 0), cB, voffB); PG8_STAGE(PG8_SB(0, 1), cB + hstep, voffB); PG8_STAGE(PG8_SA(0, 0), cA, voffA); PG8_STAGE(PG8_SA(0, 1), cA + hstep, voffA);
        if (wr == 1) PG8_BAR;
        PG8_WAIT_V(2); PG8_BAR;
        PG8_STAGE(PG8_SB(1, 0), cB + kstep, voffB); PG8_STAGE(PG8_SA(1, 0), cA + kstep, voffA); PG8_STAGE(PG8_SB(1, 1), cB + hstep + kstep, voffB);
        PG8_WAIT_V(6); PG8_BAR;
    } else {
        PG8_STAGE(PG8_SB(0, 0), cB, voffB); PG8_STAGE(PG8_SA(0, 0), cA, voffA); PG8_STAGE(PG8_SB(0, 1), cB + hstep, voffB); PG8_STAGE(PG8_SA(0, 1), cA + hstep, voffA);
        if (wr == 1) PG8_BAR;
        PG8_WAIT_V(4); PG8_BAR;
        PG8_STAGE(PG8_SB(1, 0), cB + kstep, voffB); PG8_STAGE(PG8_SA(1, 0), cA + kstep, voffA); PG8_STAGE(PG8_SB(1, 1), cB + hstep + kstep, voffB);
        PG8_WAIT_V(6); PG8_BAR;
    }
    for (;;) {
        const bool has_next = S.next(ui + 1, nxt);
        const char* nA = has_next ? (const char*)g.A + (size_t)nxt.pm * tstep : cA; const char* nB = has_next ? (const char*)g.Bt + (size_t)nxt.pn * tstep : cB;
        for (int t = 0; t < nt; t += 2) {
            const bool last = (t == nt - 2);
            const char* a1 = cA + (size_t)(t + 1) * kstep;
            const char* a2 = last ? nA : cA + (size_t)(t + 2) * kstep; const char* b2 = last ? nB : cB + (size_t)(t + 2) * kstep;
            const char* a3 = a2 + kstep; const char* b3 = b2 + kstep;
            if (last && has_next) S.a_ready(nxt);
            if constexpr (SP2) {
            PG8_LDB(B0, 0, 0); PG8_LDB(B1, 0, 1); PG8_SCHED; PG8_LDA(At, 0, 0); PG8_STAGE(PG8_SA(1, 1), a1 + hstep, voffA);
            PG8_WAIT_V(8); PG8_WAIT_L(0); PG8_BAR; PG8_MMA(0, 0, At, B0); PG8_MMA(0, 1, At, B1); PG8_BAR; PG8_SCHED;
            PG8_LDA(At, 0, 1); PG8_STAGE(PG8_SB(0, 0), b2, voffB); PG8_STAGE(PG8_SB(0, 1), b2 + hstep, voffB); PG8_STAGE(PG8_SA(0, 0), a2, voffA);
            PG8_WAIT_V(8); PG8_WAIT_L(0); PG8_BAR; PG8_MMA(1, 0, At, B0); PG8_MMA(1, 1, At, B1); PG8_BAR; PG8_SCHED;
            PG8_LDB(B0, 1, 0); PG8_LDB(B1, 1, 1); PG8_SCHED; PG8_LDA(At, 1, 0); PG8_STAGE(PG8_SA(0, 1), a2 + hstep, voffA);
            PG8_WAIT_V(8); PG8_WAIT_L(0); PG8_BAR; PG8_MMA(0, 0, At, B0); PG8_MMA(0, 1, At, B1); PG8_BAR; PG8_SCHED;
            PG8_LDA(At, 1, 1); PG8_STAGE(PG8_SB(1, 0), b3, voffB); PG8_STAGE(PG8_SB(1, 1), b3 + hstep, voffB); PG8_STAGE(PG8_SA(1, 0), a3, voffA);
            PG8_WAIT_V(8); PG8_WAIT_L(0); PG8_BAR; PG8_MMA(1, 0, At, B0); PG8_MMA(1, 1, At, B1); PG8_BAR; PG8_SCHED;
            } else {
            PG8_LDB(B0, 0, 0); PG8_SCHED; PG8_LDA(At, 0, 0); PG8_STAGE(PG8_SA(1, 1), a1 + hstep, voffA);
            PG8_WAIT_L(8); PG8_BAR; PG8_WAIT_L(0); PG8_MMA(0, 0, At, B0); PG8_BAR; PG8_SCHED;
            PG8_LDB(B1, 0, 1); PG8_STAGE(PG8_SB(0, 0), b2, voffB);
            PG8_BAR; PG8_WAIT_L(0); PG8_MMA(0, 1, At, B1); PG8_BAR;
            PG8_LDA(At, 0, 1); PG8_STAGE(PG8_SA(0, 0), a2, voffA);
            PG8_BAR; PG8_WAIT_L(0); PG8_MMA(1, 0, At, B0); PG8_BAR; PG8_SCHED;
            PG8_STAGE(PG8_SB(0, 1), b2 + hstep, voffB);
            PG8_WAIT_V(6); PG8_BAR; PG8_MMA(1, 1, At, B1); PG8_BAR;
            PG8_LDB(B0, 1, 0); PG8_SCHED; PG8_LDA(At, 1, 0); PG8_STAGE(PG8_SA(0, 1), a2 + hstep, voffA);
            PG8_WAIT_L(8); PG8_BAR; PG8_WAIT_L(0); PG8_MMA(0, 0, At, B0); PG8_BAR; PG8_SCHED;
            PG8_LDB(B1, 1, 1); PG8_STAGE(PG8_SB(1, 0), b3, voffB);
            PG8_BAR; PG8_WAIT_L(0); PG8_MMA(0, 1, At, B1); PG8_BAR;
            PG8_LDA(At, 1, 1); PG8_STAGE(PG8_SA(1, 0), a3, voffA);
            PG8_BAR; PG8_WAIT_L(0); PG8_MMA(1, 0, At, B0); PG8_BAR; PG8_SCHED;
            PG8_STAGE(PG8_SB(1, 1), b3 + hstep, voffB);
            PG8_WAIT_V(6); PG8_BAR; PG8_MMA(1, 1, At, B1); PG8_BAR;
            }
        }
        if constexpr (ALIGN_EPI) { if (wr == 0) PG8_BAR; }
        if constexpr (!Epi::AFTER_DRAIN) { E(acc, cur, wr, wc, fr, fq); S.done(cur); }
        if (!has_next) break;
#pragma unroll
        for (int a = 0; a < 2; ++a)
#pragma unroll
            for (int b = 0; b < 2; ++b)
#pragma unroll
                for (int m = 0; m < 4; ++m)
#pragma unroll
                    for (int n = 0; n < 2; ++n) acc[a][b][m][n] = (f32x4){0.f, 0.f, 0.f, 0.f};
        cur = nxt; cA = nA; cB = nB; ++ui;
        if constexpr (ALIGN_EPI) { if (wr == 1) PG8_BAR; }
    }
    PG8_WAIT_V(0);
    if constexpr (!ALIGN_EPI) { if (wr == 0) PG8_BAR; }
    PG8_BAR;
    if constexpr (Epi::AFTER_DRAIN) { E.fused(acc, cur, wr, wc, fr, fq, lds, wid, lane); S.done(cur); }
#undef PG8_SA
#undef PG8_SB
#undef PG8_STAGE
#undef PG8_LDA
#undef PG8_LDB
#undef PG8_MMA
#undef PG8_WAIT_V
#undef PG8_WAIT_L
#undef PG8_BAR
#undef PG8_SCHED
}
}
constexpr int NB = 8, SEQ = 4096, T = NB * SEQ, DM = 1024, DFF = 2816, NMEM = 256, MROWS = NB * NMEM;
constexpr float C2 = 0.125f * 1.4426950408889634f;
constexpr float SB_EXIT = -160.0f;
constexpr size_t MiB = 1u << 20;
constexpr size_t WS_W_AIN = 1 * MiB, WS_W_AOUT = 3 * MiB, WS_W_AGU = 5 * MiB, WS_W_ADOWN = 16 * MiB, WS_W_MKV = 22 * MiB, WS_W_KQV = 24 * MiB,
                 WS_W_BOUT = 30 * MiB, WS_W_BGU = 32 * MiB, WS_W_BDOWN = 43 * MiB, WS_W_GRP = 49 * MiB, WS_MEMN = 50 * MiB, WS_MEMK = 54 * MiB, WS_MEMVT = 56 * MiB,
                 WS_SS = 58 * MiB, WS_XR = 64 * MiB, WS_XB = 192 * MiB, WS_PROJ = 256 * MiB, WS_MIX = 320 * MiB, WS_KB = 384 * MiB, WS_VT = 432 * MiB, WS_H = 256 * MiB, WS_END = 482 * MiB;
static_assert(WS_H + (size_t)T * DFF * 2 <= WS_VT, "h overlays PROJ|MIX|KB only");

namespace mix {
#define DI __device__ __forceinline__
typedef unsigned short bf16_t;
typedef short bf16x8 __attribute__((ext_vector_type(8)));
typedef float f32x16 __attribute__((ext_vector_type(16)));
typedef float f32x4 __attribute__((ext_vector_type(4)));
typedef unsigned u32x4 __attribute__((ext_vector_type(4)));
#define MFMA32(a, b, c) __builtin_amdgcn_mfma_f32_32x32x16_bf16((a), (b), (c), 0, 0, 0)
DI int pi32(int i) { return (i & 0x13) | ((i & 4) << 1) | ((i & 8) >> 1); }
DI unsigned pk2(float lo, float hi) { return pg8::cvt_pk_bf16(lo, hi); }
DI bf16x8 pack8(float a0, float a1, float a2, float a3, float a4, float a5, float a6, float a7) { u32x4 w; w.x = pk2(a0, a1); w.y = pk2(a2, a3); w.z = pk2(a4, a5); w.w = pk2(a6, a7); return __builtin_bit_cast(bf16x8, w); }
#define PACK8(P, B) pack8(P[(B)], P[(B) + 1], P[(B) + 2], P[(B) + 3], P[(B) + 4], P[(B) + 5], P[(B) + 6], P[(B) + 7])
DI bf16x8 ld8(const bf16_t* p) { return *(const bf16x8*)p; }
DI bf16x8 ldo(const void* base, unsigned off) { return *(const bf16x8*)((const char*)base + off); }
DI void sto8(void* base, unsigned off, const f32x16& o, int b) { u32x4 w; w.x = pk2(o[b], o[b + 1]); w.y = pk2(o[b + 2], o[b + 3]); w.z = pk2(o[b + 4], o[b + 5]); w.w = pk2(o[b + 6], o[b + 7]); *(u32x4*)((char*)base + off) = w; }
DI void halves(float v, float& lo, float& hi) { auto rr = __builtin_amdgcn_permlane32_swap(__float_as_uint(v), __float_as_uint(v), false, false); lo = __uint_as_float(rr[0]); hi = __uint_as_float(rr[1]); }
DI void store_o8(bf16_t* p, const f32x16& o, int b) { u32x4 w; w.x = pk2(o[b], o[b + 1]); w.y = pk2(o[b + 2], o[b + 3]); w.z = pk2(o[b + 4], o[b + 5]); w.w = pk2(o[b + 6], o[b + 7]); *(u32x4*)p = w; }

template <bool MASKED> DI void sb_group(f32x16& P, const int B, const int keyb, const int t, float& gt) {
    float run = 1.f;
#pragma unroll
    for (int i = 7; i >= 0; --i) {
        const float e = __builtin_amdgcn_exp2f(__builtin_amdgcn_fmed3f(-P[B + i], -126.f, 126.f));
        float beta = __builtin_amdgcn_rcpf(1.0f + e), nb = e * beta;
        if (MASKED) { const bool valid = (keyb + i) < t; beta = valid ? beta : 0.f; nb = valid ? nb : 1.f; }
        P[B + i] = beta * run;
        run *= nb;
    }
    gt = run;
}
template <bool MASKED> DI void sb_tile(f32x16& p0, f32x16& p1, float& carry, const int key0, const int t, const int hh) {
    float g0, g1, g2, g3;
    sb_group<MASKED>(p0, 0, key0 + 8 * hh, t, g0); sb_group<MASKED>(p0, 8, key0 + 16 + 8 * hh, t, g1);
    sb_group<MASKED>(p1, 0, key0 + 32 + 8 * hh, t, g2); sb_group<MASKED>(p1, 8, key0 + 48 + 8 * hh, t, g3);
    float l0, h0, l1, h1, l2, h2, l3, h3; halves(g0, l0, h0); halves(g1, l1, h1); halves(g2, l2, h2); halves(g3, l3, h3);
    const float t3 = l3 * h3, t2 = l2 * h2, t1 = l1 * h1, t0 = l0 * h0;
    const float c3 = __builtin_amdgcn_exp2f(carry), c2 = c3 * t3, c1 = c2 * t2, c0 = c1 * t1;
    const float o0 = hh ? c0 : c0 * h0, o1 = hh ? c1 : c1 * h1, o2 = hh ? c2 : c2 * h2, o3 = hh ? c3 : c3 * h3;
#pragma unroll
    for (int i = 0; i < 8; ++i) { p0[i] *= o0; p0[8 + i] *= o1; p1[i] *= o2; p1[8 + i] *= o3; }
    carry += (__builtin_amdgcn_logf(t3) + __builtin_amdgcn_logf(t2)) + (__builtin_amdgcn_logf(t1) + __builtin_amdgcn_logf(t0));
}
template <bool MASKED> DI bool sb_step(bf16x8 (&kf)[2][4], const bf16x8 (&qf)[4], f32x16& o0, f32x16& o1, float& carry, const int j, const int t, const int hh,
                                       const bf16_t* ku, const bf16_t* vu, const unsigned loff) {
    const int key0 = j * 64;
    f32x16 p0 = {}, p1 = {};
#pragma unroll
    for (int s = 0; s < 4; ++s) { p0 = MFMA32(kf[0][s], qf[s], p0); p1 = MFMA32(kf[1][s], qf[s], p1); }
    bf16x8 vf[2][4];
#pragma unroll
    for (int dt = 0; dt < 2; ++dt)
#pragma unroll
        for (int s = 0; s < 4; ++s) vf[dt][s] = ldo(vu + (size_t)j * 4096, loff + (dt * 4 + s) * 1024);
    if (j > 0) {
#pragma unroll
        for (int hf = 0; hf < 2; ++hf)
#pragma unroll
            for (int s = 0; s < 4; ++s) kf[hf][s] = ldo(ku + (size_t)(j - 1) * 4096, loff + (hf * 4 + s) * 1024);
    }
    sb_tile<MASKED>(p0, p1, carry, key0, t, hh);
    const bf16x8 w0 = PACK8(p0, 0), w1 = PACK8(p0, 8), w2 = PACK8(p1, 0), w3 = PACK8(p1, 8);
    o0 = MFMA32(vf[0][0], w0, o0); o1 = MFMA32(vf[1][0], w0, o1);
    o0 = MFMA32(vf[0][1], w1, o0); o1 = MFMA32(vf[1][1], w1, o1);
    o0 = MFMA32(vf[0][2], w2, o0); o1 = MFMA32(vf[1][2], w2, o1);
    o0 = MFMA32(vf[0][3], w3, o0); o1 = MFMA32(vf[1][3], w3, o1);
    return j == 0 || __all(carry < SB_EXIT);
}
DI void sb_unit(const bf16_t* __restrict__ Q, const bf16_t* __restrict__ Kb, const bf16_t* __restrict__ VT, bf16_t* __restrict__ O, const int b, const int h, const int q0, int lane) {
    asm volatile("" : "+v"(lane));
    const int li = lane & 31, hh = lane >> 5, t = q0 + li;
    const size_t trow = (size_t)b * SEQ;
    const bf16_t* qu = Q + (trow + q0) * 1024 + h * 64;
    const bf16_t* ku = Kb + (size_t)(b * 12 + h) * (SEQ * 64);
    const bf16_t* vu = VT + (size_t)(b * 12 + h) * (SEQ * 64);
    bf16_t* ou = O + (trow + q0) * 1024 + h * 64;
    const unsigned qoff = (unsigned)(li * 1024 + hh * 8) * 2u, loff = (unsigned)lane * 16u;
    bf16x8 qf[4];
#pragma unroll
    for (int s = 0; s < 4; ++s) qf[s] = ldo(qu, qoff + 32 * s);
    f32x16 o0 = {}, o1 = {}; float carry = 0.f;
    int j = (q0 + 30) >> 6;
    bf16x8 kf[2][4];
#pragma unroll
    for (int hf = 0; hf < 2; ++hf)
#pragma unroll
        for (int s = 0; s < 4; ++s) kf[hf][s] = ldo(ku + (size_t)j * 4096, loff + (hf * 4 + s) * 1024);
    bool done = sb_step<true>(kf, qf, o0, o1, carry, j, t, hh, ku, vu, loff);
    while (!done) { --j; done = sb_step<false>(kf, qf, o0, o1, carry, j, t, hh, ku, vu, loff); }
    sto8(ou, qoff, o0, 0); sto8(ou, qoff + 32, o0, 8); sto8(ou, qoff + 64, o1, 0); sto8(ou, qoff + 96, o1, 8);
}
DI void memkv_unit(const bf16_t* __restrict__ MNF, const bf16_t* __restrict__ WF, bf16_t* __restrict__ MK, bf16_t* __restrict__ MVT, const int u, int lane) {
    asm volatile("" : "+v"(lane));
    const int li = lane & 31, hh = lane >> 5;
    const bool isv = u >= 1024; const int v = u & 1023, tt = v & 63, dt = (v >> 6) & 1, hd = v >> 7;
    const bf16_t* wt = WF + (size_t)(((isv ? 16 : 0) + hd * 2 + dt) * 64) * 512;
    const bf16_t* mt = MNF + (size_t)(tt * 64) * 512;
    const unsigned loff = (unsigned)lane * 16u, poff = (unsigned)(pi32(li) + 32 * hh) * 16u;
    const bf16_t* pa = isv ? mt : wt; const bf16_t* pb = isv ? wt : mt; const unsigned oa = isv ? poff : loff;
    f32x16 acc = {}, acc2 = {};
#pragma unroll 1
    for (int s0 = 0; s0 < 64; s0 += 16) {
        bf16x8 fa[16], fb[16];
#pragma unroll
        for (int s = 0; s < 16; ++s) { fa[s] = ldo(pa + (s0 + s) * 512, oa); fb[s] = ldo(pb + (s0 + s) * 512, loff); }
#pragma unroll
        for (int s = 0; s < 16; s += 2) { acc = MFMA32(fa[s], fb[s], acc); acc2 = MFMA32(fa[s + 1], fb[s + 1], acc2); }
    }
    acc = acc + acc2;
    const int tok0 = tt * 32, b = tok0 >> 8, key0 = tok0 & 255, tile = key0 >> 6;
    if (!isv) {
        bf16_t* o = MK + ((size_t)(((b * 8 + hd) * 4 + tile) * 8 + ((key0 >> 5) & 1) * 4 + dt * 2)) * 512;
        sto8(o, poff, acc, 0); sto8(o + 512, poff, acc, 8);
    } else {
        bf16_t* o = MVT + ((size_t)(((b * 8 + hd) * 4 + tile) * 8 + dt * 4 + ((key0 >> 4) & 3))) * 512;
        sto8(o, loff, acc, 0); sto8(o + 512, loff, acc, 8);
    }
}
DI void mem_unit(const bf16_t* __restrict__ Q, const int ldq, const bf16_t* __restrict__ MK, const bf16_t* __restrict__ MVT, bf16_t* __restrict__ O, const int row0, const int hm, const int lay, int lane) {
    asm volatile("" : "+v"(lane));
    const int li = lane & 31, hh = lane >> 5, b = row0 / SEQ;
    const bf16_t* qu = Q + (size_t)row0 * ldq + hm * 64;
    const bf16_t* ku = MK + (size_t)((b * 8 + lay * 4 + hm) * 4) * 4096;
    const bf16_t* vu = MVT + (size_t)((b * 8 + lay * 4 + hm) * 4) * 4096;
    bf16_t* ou = O + (size_t)row0 * 1024 + 768 + hm * 64;
    const unsigned qoff = (unsigned)(li * ldq + hh * 8) * 2u, ooff = (unsigned)(li * 1024 + hh * 8) * 2u, loff = (unsigned)lane * 16u;
    bf16x8 qf[4];
#pragma unroll
    for (int s = 0; s < 4; ++s) qf[s] = ldo(qu, qoff + 32 * s);
    f32x16 o0 = {}, o1 = {}; float mrun = -1e30f, lsum = 0.f;
    bf16x8 kf[2][4], vf[2][4];
#pragma unroll
    for (int hf = 0; hf < 2; ++hf)
#pragma unroll
        for (int s = 0; s < 4; ++s) kf[hf][s] = ldo(ku, loff + (hf * 4 + s) * 1024);
#pragma unroll 1
    for (int c = 0; c < 4; ++c) {
        bf16x8 kn[2][4];
#pragma unroll
        for (int dt = 0; dt < 2; ++dt)
#pragma unroll
            for (int s = 0; s < 4; ++s) vf[dt][s] = ldo(vu + c * 4096, loff + (dt * 4 + s) * 1024);
        { const int cn = c < 3 ? c + 1 : 3;
#pragma unroll
            for (int hf = 0; hf < 2; ++hf)
#pragma unroll
                for (int s = 0; s < 4; ++s) kn[hf][s] = ldo(ku + cn * 4096, loff + (hf * 4 + s) * 1024);
        }
        f32x16 p0 = {}, p1 = {};
#pragma unroll
        for (int s = 0; s < 4; ++s) { p0 = MFMA32(kf[0][s], qf[s], p0); p1 = MFMA32(kf[1][s], qf[s], p1); }
        float mx = __builtin_fmaxf(p0[0], p1[0]);
#pragma unroll
        for (int i = 1; i < 16; ++i) mx = __builtin_fmaxf(mx, __builtin_fmaxf(p0[i], p1[i]));
        float ml, mh; halves(mx, ml, mh); mx = __builtin_fmaxf(ml, mh);
        const float mnew = __builtin_fmaxf(mrun, mx), alpha = __builtin_amdgcn_exp2f(mrun - mnew); mrun = mnew;
        float ps = 0.f;
#pragma unroll
        for (int i = 0; i < 16; ++i) { p0[i] = __builtin_amdgcn_exp2f(p0[i] - mnew); p1[i] = __builtin_amdgcn_exp2f(p1[i] - mnew); ps += p0[i] + p1[i]; }
        lsum = lsum * alpha + ps;
#pragma unroll
        for (int i = 0; i < 16; ++i) { o0[i] *= alpha; o1[i] *= alpha; }
        const bf16x8 w0 = PACK8(p0, 0), w1 = PACK8(p0, 8), w2 = PACK8(p1, 0), w3 = PACK8(p1, 8);
        o0 = MFMA32(vf[0][0], w0, o0); o1 = MFMA32(vf[1][0], w0, o1);
        o0 = MFMA32(vf[0][1], w1, o0); o1 = MFMA32(vf[1][1], w1, o1);
        o0 = MFMA32(vf[0][2], w2, o0); o1 = MFMA32(vf[1][2], w2, o1);
        o0 = MFMA32(vf[0][3], w3, o0); o1 = MFMA32(vf[1][3], w3, o1);
#pragma unroll
        for (int x = 0; x < 2; ++x)
#pragma unroll
            for (int s = 0; s < 4; ++s) kf[x][s] = kn[x][s];
    }
    float ll, lh; halves(lsum, ll, lh); const float inv = 1.0f / (ll + lh);
#pragma unroll
    for (int i = 0; i < 16; ++i) { o0[i] *= inv; o1[i] *= inv; }
    sto8(ou, ooff, o0, 0); sto8(ou, ooff + 32, o0, 8); sto8(ou, ooff + 64, o1, 0); sto8(ou, ooff + 96, o1, 8);
}
template <int GI> DI void pool_unit_t(const bf16_t* __restrict__ U, const bf16_t* __restrict__ WG, bf16_t* __restrict__ O, const int row0, int lane) {
    asm volatile("" : "+v"(lane));
    constexpr int w = 2 << GI;
    const int li = lane & 31, hh = lane >> 5, pos = (row0 & (SEQ - 1)) + li;
    const int cnt = (pos + 1) < w ? (pos + 1) : w; const float rc = 1.0f / (float)cnt;
    const char* ub = (const char*)(U + ((size_t)(row0 >> 5) * 48 + GI * 12) * 512) - 48 * 1024;
    bf16_t* ou = O + (size_t)row0 * 1024 + GI * 192;
    const unsigned ooff = (unsigned)(li * 1024 + hh * 8) * 2u, loff = (unsigned)lane * 16u;
    const float nextra = (float)((w - 1 - pos) > 0 ? (w - 1 - pos) : 0);
    f32x16 o[6];
#pragma unroll
    for (int d = 0; d < 6; ++d) o[d] = f32x16{};
#pragma unroll 1
    for (int s = 0; s < 12; ++s) {
        const u32x4 v0 = *(const u32x4*)(ub + (unsigned)(48 * 1024 + s * 1024) + loff);
        bf16x8 wf[6];
#pragma unroll
        for (int d = 0; d < 6; ++d) wf[d] = ldo(WG, loff + (d * 12 + s) * 1024);
        float cur[8], sum[8], last[8];
#pragma unroll
        for (int e = 0; e < 4; ++e) { cur[2 * e] = __uint_as_float(v0[e] << 16); cur[2 * e + 1] = __uint_as_float(v0[e] & 0xffff0000u); sum[2 * e] = cur[2 * e]; sum[2 * e + 1] = cur[2 * e + 1]; }
#pragma unroll
        for (int i0 = 1; i0 < w; i0 += 8) {
            constexpr int NBATCH = 8;
            u32x4 v[NBATCH];
#pragma unroll
            for (int i = 0; i < NBATCH; ++i) if (i0 + i < w) { const int ie = (i0 + i) < pos ? (i0 + i) : pos, rr = li - ie;
                v[i] = *(const u32x4*)(ub + ((unsigned)(((rr >> 5) + 1) * (48 * 1024) + s * 1024) + (unsigned)(((rr & 31) + 32 * hh) * 16))); }
#pragma unroll
            for (int i = 0; i < NBATCH; ++i) if (i0 + i < w) {
#pragma unroll
                for (int e = 0; e < 4; ++e) { const float lo = __uint_as_float(v[i][e] << 16), hi = __uint_as_float(v[i][e] & 0xffff0000u); sum[2 * e] += lo; sum[2 * e + 1] += hi; if (i0 + i == w - 1) { last[2 * e] = lo; last[2 * e + 1] = hi; } } }
        }
        const bf16x8 pf = pack8((sum[0] - nextra * last[0]) * rc - cur[0], (sum[1] - nextra * last[1]) * rc - cur[1], (sum[2] - nextra * last[2]) * rc - cur[2], (sum[3] - nextra * last[3]) * rc - cur[3],
                                (sum[4] - nextra * last[4]) * rc - cur[4], (sum[5] - nextra * last[5]) * rc - cur[5], (sum[6] - nextra * last[6]) * rc - cur[6], (sum[7] - nextra * last[7]) * rc - cur[7]);
#pragma unroll
        for (int d = 0; d < 6; ++d) o[d] = MFMA32(wf[d], pf, o[d]);
    }
#pragma unroll
    for (int d = 0; d < 6; ++d) { sto8(ou, ooff + d * 64, o[d], 0); sto8(ou, ooff + d * 64 + 32, o[d], 8); }
}
DI void pool_unit(const bf16_t* __restrict__ U, const bf16_t* __restrict__ WG, bf16_t* __restrict__ O, const int row0, const int g, const int lane) {
    if (g == 0) pool_unit_t<0>(U, WG, O, row0, lane); else if (g == 1) pool_unit_t<1>(U, WG, O, row0, lane); else if (g == 2) pool_unit_t<2>(U, WG, O, row0, lane); else pool_unit_t<3>(U, WG, O, row0, lane);
}
}
#define LAS __attribute__((address_space(3)))
typedef unsigned short bf16;
typedef unsigned v4u __attribute__((ext_vector_type(4)));
typedef float f32x4 __attribute__((ext_vector_type(4)));
__device__ __forceinline__ float wave_sum(float v) {
#pragma unroll
    for (int o = 1; o < 64; o <<= 1) v += __shfl_xor(v, o);
    return v;
}
__device__ __forceinline__ void tr_item(const float* __restrict__ W, int N, int k0, int n0, bf16* dst, int Kld, const float* gk, const float* cn, LAS float* scr, int lane, bf16* fragbase = nullptr, int fragkb = 12, int fragrow0 = 0) {
    const int c4 = (lane & 15) * 4, kr = lane >> 4;
    f32x4 cs = {1.f, 1.f, 1.f, 1.f}; if (cn) cs = *(const f32x4*)(cn + n0 + c4);
    const float* wp = W + (size_t)(k0 + kr) * N + n0 + c4;
    f32x4 v[16];
#pragma unroll
    for (int i = 0; i < 16; ++i) v[i] = __builtin_nontemporal_load((const f32x4*)(wp + (size_t)(4 * i) * N));
#pragma unroll
    for (int i = 0; i < 16; ++i) { const int kk = 4 * i + kr; f32x4 x = v[i] * cs; if (gk) x = x * gk[k0 + kk];
        LAS float* d = scr + kk * 65 + c4; d[0] = x[0]; d[1] = x[1]; d[2] = x[2]; d[3] = x[3]; }
    asm volatile("s_waitcnt lgkmcnt(0)" ::: "memory");
    const int c = lane & 7;
#pragma unroll
    for (int j = 0; j < 8; ++j) { const int n = (lane >> 3) + 8 * j; const LAS float* s = scr + (8 * c) * 65 + n;
        v4u o; o.x = pg8::cvt_pk_bf16(s[0 * 65], s[1 * 65]); o.y = pg8::cvt_pk_bf16(s[2 * 65], s[3 * 65]); o.z = pg8::cvt_pk_bf16(s[4 * 65], s[5 * 65]); o.w = pg8::cvt_pk_bf16(s[6 * 65], s[7 * 65]);
        if (fragbase) { const int ng = fragrow0 + n, kg = k0 + 8 * c, ni = ng & 31, pn = (ni & 0x13) | ((ni & 4) << 1) | ((ni & 8) >> 1);
            *(v4u*)(fragbase + ((size_t)(ng >> 5) * fragkb + (kg >> 4)) * 512 + (pn + 32 * ((kg >> 3) & 1)) * 8) = o; }
        else *(v4u*)(dst + (size_t)n * Kld + 8 * c) = o; }
    asm volatile("s_waitcnt lgkmcnt(0)" ::: "memory");
}
__device__ __forceinline__ int rowmap(int mode, int n0) {
    switch (mode) {
        case 1: return n0 < 256 ? n0 : 512 + (n0 - 256);
        case 2: return n0 < 256 ? 256 + n0 : 768 + (n0 - 256);
        case 3: { const int f = n0 < DFF ? n0 : n0 - DFF; return (f / 128) * 256 + (n0 < DFF ? 0 : 128) + (f % 128); }
        case 4: return n0 < 768 ? n0 : n0 + 1024;
        case 5: return 768 + n0;
        default: return n0;
    }
}
#define XB_TMO      128
#define XB_XCNT(j)  (256  + 64 * (j))
#define XB_XSUB(j)  (1280 + 64 * (j))
#define XB_XGEN(j)  (2304 + 64 * (j))
#define XB_TOP      3328
#define XB_TOPGEN   3392
#define XCD_BAR_WORDS 3456
#define XB_SPIN_CAP (1u << 18)

__device__ __forceinline__ unsigned xb_ld(unsigned* p)              { return __hip_atomic_load(p, __ATOMIC_RELAXED, __HIP_MEMORY_SCOPE_AGENT); }
__device__ __forceinline__ unsigned xb_add(unsigned* p, unsigned v) { return __hip_atomic_fetch_add(p, v, __ATOMIC_RELAXED, __HIP_MEMORY_SCOPE_AGENT); }
__device__ __forceinline__ unsigned xb_xcc_id() { return (unsigned)__builtin_amdgcn_s_getreg((3 << 11) | 20) & 0xFu; }
#define XB_SPIN(cond, bar) do { unsigned _sp = 0; while (cond) { __builtin_amdgcn_s_sleep(1); \
    if ((++_sp & 255u) == 0u) { if (xb_ld(&(bar)[XB_TMO])) break; if (_sp > XB_SPIN_CAP) { atomicAdd(&(bar)[XB_TMO], 1u); break; } } } } while (0)

struct XcdBarrier {
    unsigned* bar; unsigned x;
    volatile LAS unsigned* st;
};

__device__ __forceinline__ XcdBarrier xcd_barrier_post(unsigned* bar, volatile LAS unsigned* st) {
    XcdBarrier b; b.bar = bar; b.x = xb_xcc_id(); b.st = st;
    if (threadIdx.x == 0) (void)xb_add(&bar[XB_XCNT(b.x)], 1u);
    return b;
}
__device__ __forceinline__ void xcd_barrier_complete(unsigned* bar, unsigned x, unsigned& nloc, unsigned& nx) {
    const unsigned G = gridDim.x * gridDim.y * gridDim.z;
    unsigned sum, cnt, mine, sp = 0u;
    for (;;) {
        sum = 0u; cnt = 0u; mine = 0u;
#pragma unroll
        for (unsigned j = 0; j < 16; ++j) { const unsigned c = xb_ld(&bar[XB_XCNT(j)]); sum += c; cnt += (c > 0u) ? 1u : 0u; mine = (j == x) ? c : mine; }
        if (sum == G) break;
        __builtin_amdgcn_s_sleep(1);
        if ((++sp & 255u) == 0u) { if (xb_ld(&bar[XB_TMO])) break; if (sp > XB_SPIN_CAP) { atomicAdd(&bar[XB_TMO], 1u); break; } }
    }
    nloc = mine > 0u ? mine : 1u; nx = cnt > 0u ? cnt : 1u;
}

__device__ __forceinline__ void xcd_barrier(const XcdBarrier& b) {
    asm volatile("s_waitcnt vmcnt(0)" ::: "memory");
    __syncthreads();
    if (threadIdx.x == 0) {
        unsigned* bar = b.bar;
        __builtin_amdgcn_s_waitcnt(0);
        unsigned nloc = b.st[0], nx = b.st[1];
        if (nloc == 0u) { xcd_barrier_complete(bar, b.x, nloc, nx); b.st[0] = nloc; b.st[1] = nx; }
        const unsigned old = xb_add(&bar[XB_XSUB(b.x)], 1u);
        const unsigned gen = old / nloc;
        if (old + 1u == (gen + 1u) * nloc) {
            __builtin_amdgcn_fence(__ATOMIC_RELEASE, "agent");
            asm volatile("s_waitcnt vmcnt(0)" ::: "memory");
            const unsigned og = xb_add(&bar[XB_TOP], 1u);
            const unsigned tg = og / nx;
            if (og + 1u == (tg + 1u) * nx) xb_add(&bar[XB_TOPGEN], 1u);
            else XB_SPIN(xb_ld(&bar[XB_TOPGEN]) == tg, bar);
            __builtin_amdgcn_fence(__ATOMIC_ACQUIRE, "agent");
            xb_add(&bar[XB_XGEN(b.x)], 1u);
            asm volatile("s_waitcnt vmcnt(0)" ::: "memory");
        } else {
            XB_SPIN(xb_ld(&bar[XB_XGEN(b.x)]) == gen, bar);
            __builtin_amdgcn_fence(__ATOMIC_ACQUIRE, "agent");
            asm volatile("s_waitcnt vmcnt(0)" ::: "memory");
        }
    }
    __syncthreads();
}

#ifndef REP_PRO
#define REP_PRO 1
#endif
#ifndef REP_MIXA
#define REP_MIXA 1
#endif
#ifndef REP_MIXB
#define REP_MIXB 1
#endif
#ifndef REP_FIN
#define REP_FIN 1
#endif
#ifndef REP_UP
#define REP_UP 1
#endif
struct Args { const float* in[22]; float* out; unsigned char* ws; };

__global__ void __launch_bounds__(512, 2) yoco_fwd(Args a) {
    extern __shared__ __attribute__((aligned(16))) unsigned char lds_raw[];
    cg::grid_group grid = cg::this_grid();
    LAS unsigned char* lds = (LAS unsigned char*)lds_raw;
    const int tid = threadIdx.x, wave = __builtin_amdgcn_readfirstlane(tid >> 6);
    const int G = gridDim.x, bx = blockIdx.x, vcu = (G % 8 == 0) ? (bx % 8) * (G / 8) + bx / 8 : bx;
    const int gw = vcu * 8 + wave, NGW = G * 8;
    volatile LAS unsigned* MISC = (volatile LAS unsigned*)(lds + 134144);
    if (tid < 16) MISC[tid] = 0u;
    __syncthreads();
    const XcdBarrier xbar = xcd_barrier_post((unsigned*)a.ws, MISC + 8);
    if (a.out == nullptr) grid.sync();
#define GSYNC() xcd_barrier(xbar)
#define WSP(T_, off) ((T_*)(a.ws + (off)))
#define W_AIN WSP(bf16, WS_W_AIN)
#define W_AOUT WSP(bf16, WS_W_AOUT)
#define W_AGU WSP(bf16, WS_W_AGU)
#define W_ADOWN WSP(bf16, WS_W_ADOWN)
#define W_MKV WSP(bf16, WS_W_MKV)
#define W_KQV WSP(bf16, WS_W_KQV)
#define W_BOUT WSP(bf16, WS_W_BOUT)
#define W_BGU WSP(bf16, WS_W_BGU)
#define W_BDOWN WSP(bf16, WS_W_BDOWN)
#define W_GRP WSP(bf16, WS_W_GRP)
#define MEMN WSP(bf16, WS_MEMN)
#define MEMK WSP(bf16, WS_MEMK)
#define MEMVT WSP(bf16, WS_MEMVT)
#define SS WSP(float, WS_SS)
#define XB WSP(bf16, WS_XB)
#define PROJ WSP(bf16, WS_PROJ)
#define MIX WSP(bf16, WS_MIX)
#define QMA (PROJ + (size_t)T * 768)
#define KB WSP(bf16, WS_KB)
#define VT WSP(bf16, WS_VT)
#define HB WSP(bf16, WS_H)
#define GEMM_SCALE(gA, gB, gM, gN, gK, e0, e1, ld0, ld1, csplit, sc1, rss, css, vtb) do { pg8::Gemm g{gA, gB, gM, gN, gK}; pg8::StaticOrder S; S.init(gM, gN, G, bx); \
        pg8::EpiScale E{e0, e1, rss, css, ld0, ld1, csplit, sc1, vtb, 12, 12}; pg8::gemm_phase<pg8::EpiScale, pg8::StaticOrder, true, true>(lds, g, S, E); } while (0)
#define GEMM_SWIGLU(gA, gB, rss) do { pg8::Gemm g{gA, gB, T, 2 * DFF, 1024}; pg8::StaticOrder S; S.init(T, 2 * DFF, G, bx); \
        pg8::EpiSwiglu E{HB, rss, DFF}; pg8::gemm_phase<pg8::EpiSwiglu, pg8::StaticOrder, true, true>(lds, g, S, E); } while (0)
#define GEMM_RESID(F32B, gA, gB, gK, rbase, ssout) do { pg8::Gemm g{gA, gB, T, 1024, gK}; pg8::StaticOrder S; S.init(T, 1024, G, bx); \
        pg8::EpiResid<F32B> E{rbase, XB, ssout}; pg8::gemm_phase<pg8::EpiResid<F32B>, pg8::StaticOrder, true, true>(lds, g, S, E); } while (0)
#if REP_PRO > 1
    for (int rep = 0; rep < REP_PRO; ++rep)
#endif
    {
            int lane; asm volatile("v_mbcnt_lo_u32_b32 %0, -1, 0\n\tv_mbcnt_hi_u32_b32 %0, -1, %0" : "=v"(lane));
            LAS float* scr = (LAS float*)(lds + wave * 16640);
            constexpr int NITEMS = 256 + 36 + 2 * 128 + 2 * 256 + 2 * 1408 + 2 * 704 + 384 + 256;
            for (int it = gw; it < NITEMS; it += NGW) {
                int r = it; const float* W; const float* gk = nullptr; const float* cn = nullptr; bf16* WT; bf16* frag = nullptr; int fragkb = 12; int K = 1024, N = 1024, mode = 0;
                if (r < 256) { W = a.in[4]; gk = a.in[3]; WT = W_AIN; }
                else if ((r -= 256) < 36) { const int gi = r / 9; r -= gi * 9; W = a.in[5] + gi * 36864; cn = a.in[6] + gi * 192; WT = W_GRP + gi * 36864; frag = WT; K = 192; N = 192; }
                else if ((r -= 36) < 128) { W = a.in[7]; gk = a.in[2]; WT = W_MKV; frag = W_MKV; fragkb = 64; N = 512; mode = 1; }
                else if ((r -= 128) < 128) { W = a.in[16]; gk = a.in[2]; WT = W_MKV; frag = W_MKV; fragkb = 64; N = 512; mode = 2; }
                else if ((r -= 128) < 256) { W = a.in[8]; WT = W_AOUT; }
                else if ((r -= 256) < 256) { W = a.in[17]; WT = W_BOUT; }
                else if ((r -= 256) < 1408) { W = a.in[10]; gk = a.in[9]; WT = W_AGU; N = 2 * DFF; mode = 3; }
                else if ((r -= 1408) < 1408) { W = a.in[19]; gk = a.in[18]; WT = W_BGU; N = 2 * DFF; mode = 3; }
                else if ((r -= 1408) < 704) { W = a.in[11]; WT = W_ADOWN; K = DFF; }
                else if ((r -= 704) < 704) { W = a.in[20]; WT = W_BDOWN; K = DFF; }
                else if ((r -= 704) < 384) { W = a.in[13]; gk = a.in[12]; WT = W_KQV; N = 1536; mode = 4; }
                else { r -= 384; W = a.in[15]; gk = a.in[14]; WT = W_KQV; mode = 5; }
                const int nblk = N / 64, k0 = 64 * (r / nblk), n0 = 64 * (r % nblk);
                tr_item(W, N, k0, n0, WT + (size_t)rowmap(mode, n0) * K + k0, K, gk, cn, scr, lane, frag, fragkb, frag == W_MKV ? rowmap(mode, n0) : n0);
            }
            for (int q = gw; q < (T + MROWS) / 4; q += NGW) {
                const int m0 = q * 4; const bool ismem = m0 >= T; const float* src = ismem ? a.in[1] + (size_t)(m0 - T) * DM : a.in[0] + (size_t)m0 * DM;
                const f32x4* xr = (const f32x4*)src + lane; f32x4 v[4][4]; float s[4];
#pragma unroll
                for (int r = 0; r < 4; ++r)
#pragma unroll
                    for (int j = 0; j < 4; ++j) v[r][j] = __builtin_nontemporal_load(xr + r * 256 + 64 * j);
#pragma unroll
                for (int r = 0; r < 4; ++r) { s[r] = 0.f;
#pragma unroll
                    for (int j = 0; j < 4; ++j) s[r] += (v[r][j].x * v[r][j].x + v[r][j].y * v[r][j].y) + (v[r][j].z * v[r][j].z + v[r][j].w * v[r][j].w); }
#pragma unroll
                for (int o = 1; o < 64; o <<= 1) { s[0] += __shfl_xor(s[0], o); s[1] += __shfl_xor(s[1], o); s[2] += __shfl_xor(s[2], o); s[3] += __shfl_xor(s[3], o); }
                if (!ismem && lane < 4) SS[m0 + lane] = lane == 0 ? s[0] : lane == 1 ? s[1] : lane == 2 ? s[2] : s[3];
                unsigned long long* o8 = (unsigned long long*)(XB + (size_t)m0 * DM) + lane;
#pragma unroll
                for (int r = 0; r < 4; ++r) { const float sc = ismem ? pg8::rstd_of(s[r]) : 1.f;
#pragma unroll
                    for (int j = 0; j < 4; ++j) { const unsigned long long pk = (unsigned long long)pg8::cvt_pk_bf16(v[r][j].x * sc, v[r][j].y * sc) | ((unsigned long long)pg8::cvt_pk_bf16(v[r][j].z * sc, v[r][j].w * sc) << 32);
                        if (ismem) { const int row = m0 - T + r, k = 4 * (64 * j + lane);
                            *(unsigned long long*)(MEMN + ((size_t)(row >> 5) * 64 + (k >> 4)) * 512 + ((row & 31) + 32 * ((k >> 3) & 1)) * 8 + (k & 7)) = pk; }
                        else o8[r * 256 + 64 * j] = pk; } }
            }
            for (int i = gw * 64 + lane; i < 4 * T; i += NGW * 64) __hip_atomic_store(SS + T + i, 0.f, __ATOMIC_RELAXED, __HIP_MEMORY_SCOPE_AGENT);
    }
    GSYNC();
    GEMM_SCALE(XB, W_AIN, T, 1024, 1024, PROJ, QMA, 1024, 256, 768, C2, SS, (const float*)nullptr, 3);
    {
        int lane; asm volatile("v_mbcnt_lo_u32_b32 %0, -1, 0\n\tv_mbcnt_hi_u32_b32 %0, -1, %0" : "=v"(lane));
        for (int u = gw; u < 2048; u += NGW) mix::memkv_unit(MEMN, W_MKV, MEMK, MEMVT, u, lane);
    }
    GSYNC();
#if REP_MIXA > 1
    for (int rep = 0; rep < REP_MIXA; ++rep)
#endif
    {
            int lane; asm volatile("v_mbcnt_lo_u32_b32 %0, -1, 0\n\tv_mbcnt_hi_u32_b32 %0, -1, %0" : "=v"(lane));
            for (int i = 0; i < 2; ++i) { const int u = gw + NGW * i; if (u < 4096) mix::pool_unit(PROJ, W_GRP + (size_t)((u & 3) ^ (i ? 3 : 0)) * 36864, MIX, (u >> 2) * 32, (u & 3) ^ (i ? 3 : 0), lane); }
            for (int u = gw; u < 4096; u += NGW) mix::mem_unit(QMA, 256, MEMK, MEMVT, MIX, (u >> 2) * 32, u & 3, 0, lane);
    }
    GSYNC();
    GEMM_RESID(true, MIX, W_AOUT, 1024, a.in[0], SS + T);
    GSYNC();
#if REP_UP > 1
    for (int rep = 0; rep < REP_UP; ++rep)
#endif
    GEMM_SWIGLU(XB, W_AGU, SS + T);
    GSYNC();
    GEMM_RESID(false, HB, W_ADOWN, DFF, (const float*)nullptr, SS + 2 * T);
    GSYNC();
    {
        static_assert(WS_XB - WS_W_KQV == (size_t)pg8::KqvOrder::XT0 * 256 * 1024 * 2, "XB tile index relative to W_KQV");
        pg8::Gemm g{W_KQV, W_KQV, 0, 0, 1024}; pg8::KqvOrder S; S.init(G, bx);
        pg8::EpiKqv E{KB, PROJ, VT, SS + 2 * T}; pg8::gemm_phase<pg8::EpiKqv, pg8::KqvOrder, true, true>(lds, g, S, E);
    }
    GSYNC();
#if REP_MIXB > 1
    for (int rep = 0; rep < REP_MIXB; ++rep)
#endif
    {
            int lane; asm volatile("v_mbcnt_lo_u32_b32 %0, -1, 0\n\tv_mbcnt_hi_u32_b32 %0, -1, %0" : "=v"(lane));
            int i = 0;
            for (int u = gw; u < NB * 12 * 128; u += NGW, ++i) { const int bh = u >> 7; int qb = u & 127; if (i & 1) qb = 127 - qb; mix::sb_unit(PROJ, KB, VT, MIX, bh / 12, bh % 12, qb * 32, lane); }
            for (int u = gw; u < 4096; u += NGW) mix::mem_unit(PROJ + 768, 1024, MEMK, MEMVT, MIX, (u >> 2) * 32, u & 3, 1, lane);
    }
    GSYNC();
    GEMM_RESID(false, MIX, W_BOUT, 1024, (const float*)nullptr, SS + 3 * T);
    GSYNC();
    GEMM_SWIGLU(XB, W_BGU, SS + 3 * T);
    GSYNC();
    GEMM_RESID(false, HB, W_BDOWN, DFF, (const float*)nullptr, SS + 4 * T);
    GSYNC();
#if REP_FIN > 1
    for (int rep = 0; rep < REP_FIN; ++rep)
#endif
    {
            int lane; asm volatile("v_mbcnt_lo_u32_b32 %0, -1, 0\n\tv_mbcnt_hi_u32_b32 %0, -1, %0" : "=v"(lane));
            const f32x4* gr = (const f32x4*)a.in[21] + lane; f32x4 gv[4];
#pragma unroll
            for (int j = 0; j < 4; ++j) gv[j] = gr[64 * j];
            for (int q = gw; q < T / 4; q += NGW) { const int m0 = q * 4;
                const f32x4 ss4 = *(const f32x4*)(SS + 4 * T + m0);
                const unsigned long long* xh = (const unsigned long long*)(XB + (size_t)m0 * DM) + lane;
                f32x4* orow = (f32x4*)(a.out + (size_t)m0 * DM) + lane; unsigned long long vh[4][4];
#pragma unroll
                for (int r = 0; r < 4; ++r)
#pragma unroll
                    for (int j = 0; j < 4; ++j) vh[r][j] = __builtin_nontemporal_load(xh + r * 256 + 64 * j);
#pragma unroll
                for (int r = 0; r < 4; ++r) { const float rs = pg8::rstd_of(ss4[r]);
#pragma unroll
                    for (int j = 0; j < 4; ++j) { const unsigned h0 = (unsigned)vh[r][j], h1 = (unsigned)(vh[r][j] >> 32);
                        const f32x4 v = {__uint_as_float(h0 << 16), __uint_as_float(h0 & 0xffff0000u), __uint_as_float(h1 << 16), __uint_as_float(h1 & 0xffff0000u)};
                        __builtin_nontemporal_store(v * gv[j] * rs, orow + r * 256 + 64 * j); } } }
    }
}

extern "C" void kernel_launch(void* const* d_in, const int* in_sizes, int n_in, void* d_out, int out_size, void* d_ws, size_t ws_size, hipStream_t stream) {
    constexpr int LDS_BYTES = 135168;
    static int grid = 0;
    if (grid == 0) {
        if (n_in != 22 || ws_size < WS_END) { fprintf(stderr, "kernel_launch: unexpected inputs (n_in %d, ws %zu)\n", n_in, ws_size); grid = -1; return; }
        int dev = 0, cus = 0, per_cu = 0;
        hipGetDevice(&dev); hipDeviceGetAttribute(&cus, hipDeviceAttributeMultiprocessorCount, dev);
        if (hipFuncSetAttribute((const void*)yoco_fwd, hipFuncAttributeMaxDynamicSharedMemorySize, LDS_BYTES) != hipSuccess) { fprintf(stderr, "kernel_launch: hipFuncSetAttribute failed\n"); }
        if (hipOccupancyMaxActiveBlocksPerMultiprocessor(&per_cu, (const void*)yoco_fwd, 512, LDS_BYTES) != hipSuccess || per_cu < 1) { fprintf(stderr, "kernel_launch: occupancy query says %d\n", per_cu); per_cu = 1; }
        (void)hipGetLastError();
        grid = cus;
    }
    if (grid < 0) return;
    if (hipMemsetAsync(d_ws, 0, 16384, stream) != hipSuccess) { fprintf(stderr, "kernel_launch: memset failed\n"); return; }
    Args a{};
    for (int i = 0; i < 22; ++i) a.in[i] = (const float*)d_in[i];
    a.out = (float*)d_out; a.ws = (unsigned char*)d_ws;
    void* args[] = {&a};
    hipError_t e = hipLaunchCooperativeKernel((const void*)yoco_fwd, dim3(grid), dim3(512), args, LDS_BYTES, stream);
    if (e != hipSuccess) fprintf(stderr, "cooperative launch failed: %s (grid %d)\n", hipGetErrorString(e), grid);
}
```

```cpp
#include <hip/hip_runtime.h>
#include <hip/hip_cooperative_groups.h>
#include <cstdio>
#include <cstdint>
namespace cg = cooperative_groups;
namespace pg8 {
#define PG8_LAS __attribute__((address_space(3)))
typedef unsigned short bf16_t;
typedef short bf16x8 __attribute__((ext_vector_type(8)));
typedef float f32x4 __attribute__((ext_vector_type(4)));
typedef unsigned u32x4 __attribute__((ext_vector_type(4)));
constexpr int BM = 256, BK = 64, HALF = 128, HTB = HALF * BK * 2  , STAGE_BYTES = 8 * HTB, NXCD = 8, WGM = 8;

__host__ __device__ __forceinline__ int lds_byte(int r, int c) { const int st = (r >> 4) * 2 + (c >> 5), rr = r & 15, cc = c & 31, ob = rr * 64 + cc * 2; return st * 1024 + (ob ^ (((ob >> 9) & 1) << 5)); }
__host__ __device__ __forceinline__ void stage_rc(int b, int& R, int& C) { const int st = b / 1024, sb = b % 1024, swz = sb ^ (((sb >> 9) & 1) << 5); R = (st >> 1) * 16 + swz / 64; C = (st & 1) * 32 + (swz % 64) / 2; }
__host__ __device__ __forceinline__ int perm32(int rho) { const int n = rho >> 4, i = rho & 15; return 8 * (i >> 2) + 4 * n + (i & 3); }

struct Unit { int pm, pn; };
struct Gemm { const bf16_t* A; const bf16_t* Bt; int M, N, K; };

struct StaticOrder {
    int nM, nN, nwg, G, c;
    __host__ __device__ void init(int M, int N, int G_, int c_) { nM = M / BM; nN = N / BM; nwg = nM * nN; G = G_; c = c_; }
    __host__ __device__ bool next(int i, Unit& u) const { return at((long)i * G + c, u); }
    __host__ __device__ bool at(const long L, Unit& u) const {
        if (L >= nwg) return false;
        int wgid = (int)L; { const int q = nwg / NXCD, r = nwg % NXCD, xcd = wgid % NXCD, off = wgid / NXCD; wgid = (xcd < r ? xcd * (q + 1) : r * (q + 1) + (xcd - r) * q) + off; }
        const int nig = WGM * nN, gid = wgid / nig, fm = gid * WGM, gsz = (nM - fm) < WGM ? (nM - fm) : WGM;
        u.pm = fm + ((wgid % nig) % gsz); u.pn = (wgid % nig) / gsz; return true;
    }
    __device__ __forceinline__ void a_ready(const Unit&) const {}
    __device__ __forceinline__ void done(const Unit&) const {}
};
typedef float f32x2 __attribute__((ext_vector_type(2)));
typedef __bf16 bf16x2_t __attribute__((ext_vector_type(2)));
__device__ __forceinline__ unsigned cvt_pk_bf16(float lo, float hi) { f32x2 v = {lo, hi}; bf16x2_t b = __builtin_convertvector(v, bf16x2_t); return __builtin_bit_cast(unsigned, b); }
__device__ __forceinline__ float rstd_of(float ss) { return __builtin_amdgcn_rsqf(ss * (1.0f / 1024.0f) + 1e-6f); }

struct EpiScale {
    static constexpr bool PERM = true, AFTER_DRAIN = false;
    bf16_t* O0; bf16_t* O1; const float* rss; const float* css; int ld0, ld1, csplit; float sc1; int vtb, fseq, fnh;
    __device__ __forceinline__ void operator()(const f32x4 (&acc)[2][2][4][2], const Unit& u, int wr, int wc, int fr, int fq) const {
        int colt = u.pn * BM; bf16_t* base = O0; int ld = ld0; float sc = 1.f;
        if (colt >= csplit) { base = O1; ld = ld1; colt -= csplit; sc = sc1; }
        const int col0 = colt + wc * 32 + 8 * fq, gcol0 = u.pn * BM + wc * 32 + 8 * fq;
        const int row0 = u.pm * BM + wr * 64 + fr;
        f32x4 cs[2][2];
#pragma unroll
        for (int bj = 0; bj < 2; ++bj)
#pragma unroll
            for (int n = 0; n < 2; ++n) {
                if (css) { const f32x4 s = *(const f32x4*)(css + gcol0 + bj * HALF + 4 * n); cs[bj][n] = (f32x4){rstd_of(s[0]) * sc, rstd_of(s[1]) * sc, rstd_of(s[2]) * sc, rstd_of(s[3]) * sc}; }
                else cs[bj][n] = (f32x4){sc, sc, sc, sc};
            }
        float rsv[2][4];
#pragma unroll
        for (int ai = 0; ai < 2; ++ai)
#pragma unroll
            for (int m = 0; m < 4; ++m) rsv[ai][m] = rss ? rss[row0 + ai * HALF + m * 16] : 0.f;
#pragma unroll
        for (int ai = 0; ai < 2; ++ai)
#pragma unroll
            for (int m = 0; m < 4; ++m) rsv[ai][m] = rss ? rstd_of(rsv[ai][m]) : 1.f;
#pragma unroll
        for (int ai = 0; ai < 2; ++ai)
#pragma unroll
            for (int m = 0; m < 4; ++m) { const int row = row0 + ai * HALF + m * 16; const float rs = rsv[ai][m];
                bf16_t* rowp = base + (size_t)row * ld + col0;
                if (vtb == 1) { const int hd = row >> 6, d = row & 63, bq = col0 >> fseq, pos = col0 & ((1 << fseq) - 1), di = d & 31, pd = (di & 0x13) | ((di & 4) << 1) | ((di & 8) >> 1);
                    rowp = base + ((size_t)(((bq * fnh + hd) << (fseq - 6)) + (pos >> 6)) * 8 + (d >> 5) * 4 + ((pos >> 4) & 3)) * 512 + (pd + 32 * ((pos >> 3) & 1)) * 8; }
                else if (vtb == 2 && base == O0) { const int bq = row >> fseq, pos = row & ((1 << fseq) - 1), hd = col0 >> 6, d = col0 & 63, ki = pos & 31, pk = (ki & 0x13) | ((ki & 4) << 1) | ((ki & 8) >> 1);
                    rowp = base + ((size_t)(((bq * fnh + hd) << (fseq - 6)) + (pos >> 6)) * 8 + ((pos >> 5) & 1) * 4 + (d >> 4)) * 512 + (pk + 32 * ((d >> 3) & 1)) * 8; }
                else if (vtb == 3 && base == O0) rowp = base + ((size_t)(row >> 5) * 48 + (col0 >> 4)) * 512 + ((row & 31) + 32 * ((col0 >> 3) & 1)) * 8;
#pragma unroll
                for (int bj = 0; bj < 2; ++bj) { const f32x4 v0 = acc[ai][bj][m][0] * cs[bj][0] * rs, v1 = acc[ai][bj][m][1] * cs[bj][1] * rs;
                    u32x4 w; w.x = cvt_pk_bf16(v0[0], v0[1]); w.y = cvt_pk_bf16(v0[2], v0[3]); w.z = cvt_pk_bf16(v1[0], v1[1]); w.w = cvt_pk_bf16(v1[2], v1[3]);
                    *(u32x4*)(rowp + (vtb == 1 ? bj * 2 * 4096 : (vtb == 2 && base == O0) ? bj * ((2 * 64) << fseq) : (vtb == 3 && base == O0) ? bj * 8 * 512 : bj * HALF)) = w; } }
    }
};
struct KqvOrder {
    static constexpr int XT0 = 336, N1 = 896, N2 = 384;
    StaticOrder s1, s2; int G, c;
    __device__ void init(int G_, int c_) { G = G_; c = c_; s1.init(32768, 1792, G_, c_); s2.init(768, 32768, G_, c_); }
    __device__ bool next(int i, Unit& u) const {
        const long L = (long)i * G + c;
        if (L < N1) { s1.at(L, u); u.pm += XT0; return true; }
        if (L < N1 + N2) { s2.at(L - N1, u); u.pm += 7; u.pn += XT0; return true; }
        return false;
    }
    __device__ __forceinline__ void a_ready(const Unit&) const {}
    __device__ __forceinline__ void done(const Unit&) const {}
};
struct EpiKqv {
    static constexpr bool PERM = true, AFTER_DRAIN = false;
    bf16_t* KBp; bf16_t* PROJp; bf16_t* VTp; const float* ss;
    __device__ __forceinline__ void operator()(const f32x4 (&acc)[2][2][4][2], const Unit& u, int wr, int wc, int fr, int fq) const {
        if (u.pm >= KqvOrder::XT0) { const EpiScale E{KBp, PROJp, ss, nullptr, 768, 1024, 768, 0.125f * 1.4426950408889634f, 2, 12, 12}; const Unit v{u.pm - KqvOrder::XT0, u.pn}; E(acc, v, wr, wc, fr, fq); }
        else { const EpiScale E{VTp, VTp, nullptr, ss, 32768, 32768, 1 << 30, 1.f, 1, 12, 12}; const Unit v{u.pm - 7, u.pn - KqvOrder::XT0}; E(acc, v, wr, wc, fr, fq); }
    }
};

__device__ __forceinline__ f32x2 swiglu_pk(f32x2 a, f32x2 b, float nrs, float rs2) {
    const f32x2 t = a * nrs;
    f32x2 ex; ex.x = __builtin_amdgcn_exp2f(t.x); ex.y = __builtin_amdgcn_exp2f(t.y);
    const f32x2 d = ex + 1.0f;
    f32x2 r; r.x = __builtin_amdgcn_rcpf(d.x); r.y = __builtin_amdgcn_rcpf(d.y);
    return ((a * b) * rs2) * r;
}
struct EpiSwiglu {
    static constexpr bool PERM = true, AFTER_DRAIN = false;
    bf16_t* H; const float* rss; int ldh;
    __device__ __forceinline__ void operator()(const f32x4 (&acc)[2][2][4][2], const Unit& u, int wr, int wc, int fr, int fq) const {
        const int col0 = u.pn * HALF + wc * 32 + 8 * fq, row0 = u.pm * BM + wr * 64 + fr;
        float rsv[2][4];
#pragma unroll
        for (int ai = 0; ai < 2; ++ai)
#pragma unroll
            for (int m = 0; m < 4; ++m) rsv[ai][m] = rss[row0 + ai * HALF + m * 16];
#pragma unroll
        for (int ai = 0; ai < 2; ++ai)
#pragma unroll
            for (int m = 0; m < 4; ++m) { const int row = row0 + ai * HALF + m * 16; const float rs = rstd_of(rsv[ai][m]), nrs = rs * -1.4426950408889634f, rs2 = rs * rs;
                const f32x4 g0 = acc[ai][0][m][0], g1 = acc[ai][0][m][1], u0 = acc[ai][1][m][0], u1 = acc[ai][1][m][1];
                const f32x2 h0 = swiglu_pk((f32x2){g0[0], g0[1]}, (f32x2){u0[0], u0[1]}, nrs, rs2), h1 = swiglu_pk((f32x2){g0[2], g0[3]}, (f32x2){u0[2], u0[3]}, nrs, rs2),
                            h2 = swiglu_pk((f32x2){g1[0], g1[1]}, (f32x2){u1[0], u1[1]}, nrs, rs2), h3 = swiglu_pk((f32x2){g1[2], g1[3]}, (f32x2){u1[2], u1[3]}, nrs, rs2);
                u32x4 w; w.x = cvt_pk_bf16(h0.x, h0.y); w.y = cvt_pk_bf16(h1.x, h1.y); w.z = cvt_pk_bf16(h2.x, h2.y); w.w = cvt_pk_bf16(h3.x, h3.y);
                __builtin_nontemporal_store(w, (u32x4*)(H + (size_t)row * ldh + col0)); }
    }
};
__device__ __forceinline__ f32x4 bf_lo4(const u32x4& h, int half) { const unsigned a = half ? h.z : h.x, b = half ? h.w : h.y;
    return (f32x4){__uint_as_float(a << 16), __uint_as_float(a & 0xffff0000u), __uint_as_float(b << 16), __uint_as_float(b & 0xffff0000u)}; }
template <bool F32BASE> struct EpiResid {
    static constexpr bool PERM = true, AFTER_DRAIN = false;
    const float* base; bf16_t* XH; float* ss;
    __device__ __forceinline__ void operator()(const f32x4 (&acc)[2][2][4][2], const Unit& u, int wr, int wc, int fr, int fq) const {
        unsigned off0 = (unsigned)((u.pm * BM + wr * 64 + fr) * 1024 + u.pn * BM + wc * 32 + 8 * fq);
        asm volatile("" : "+v"(off0));
        if constexpr (F32BASE) {
#pragma unroll
            for (int ai = 0; ai < 2; ++ai) {
                f32x4 pre[4][2][2]; u32x4 w[4][2]; float sq[4];
#pragma unroll
                for (int m = 0; m < 4; ++m)
#pragma unroll
                    for (int bj = 0; bj < 2; ++bj) { const unsigned off = off0 + (unsigned)((ai * HALF + m * 16) * 1024 + bj * HALF);
                        pre[m][bj][0] = __builtin_nontemporal_load((const f32x4*)(base + off)); pre[m][bj][1] = __builtin_nontemporal_load((const f32x4*)(base + off + 4)); }
#pragma unroll
                for (int m = 0; m < 4; ++m) { float s = 0.f;
#pragma unroll
                    for (int bj = 0; bj < 2; ++bj) { const f32x4 v0 = pre[m][bj][0] + acc[ai][bj][m][0], v1 = pre[m][bj][1] + acc[ai][bj][m][1];
                        w[m][bj].x = cvt_pk_bf16(v0[0], v0[1]); w[m][bj].y = cvt_pk_bf16(v0[2], v0[3]); w[m][bj].z = cvt_pk_bf16(v1[0], v1[1]); w[m][bj].w = cvt_pk_bf16(v1[2], v1[3]);
                        s += (v0[0] * v0[0] + v0[1] * v0[1]) + (v0[2] * v0[2] + v0[3] * v0[3]) + (v1[0] * v1[0] + v1[1] * v1[1]) + (v1[2] * v1[2] + v1[3] * v1[3]); }
                    s += __shfl_xor(s, 16); s += __shfl_xor(s, 32); sq[m] = s; }
                __builtin_amdgcn_sched_barrier(0);
#pragma unroll
                for (int m = 0; m < 4; ++m) {
#pragma unroll
                    for (int bj = 0; bj < 2; ++bj) *(u32x4*)(XH + off0 + (unsigned)((ai * HALF + m * 16) * 1024 + bj * HALF)) = w[m][bj];
                    if (fq == 0) __hip_atomic_fetch_add(ss + (off0 >> 10) + ai * HALF + m * 16, sq[m], __ATOMIC_RELAXED, __HIP_MEMORY_SCOPE_AGENT); }
                __builtin_amdgcn_sched_barrier(0);
            }
        } else {
            u32x4 pre[2][4][2]; float sq[2][4];
#pragma unroll
            for (int ai = 0; ai < 2; ++ai)
#pragma unroll
                for (int m = 0; m < 4; ++m)
#pragma unroll
                    for (int bj = 0; bj < 2; ++bj) pre[ai][m][bj] = *(const u32x4*)(XH + off0 + (unsigned)((ai * HALF + m * 16) * 1024 + bj * HALF));
#pragma unroll
            for (int ai = 0; ai < 2; ++ai)
#pragma unroll
                for (int m = 0; m < 4; ++m) { float s = 0.f;
#pragma unroll
                    for (int bj = 0; bj < 2; ++bj) { const f32x4 v0 = bf_lo4(pre[ai][m][bj], 0) + acc[ai][bj][m][0], v1 = bf_lo4(pre[ai][m][bj], 1) + acc[ai][bj][m][1];
                        u32x4 w; w.x = cvt_pk_bf16(v0[0], v0[1]); w.y = cvt_pk_bf16(v0[2], v0[3]); w.z = cvt_pk_bf16(v1[0], v1[1]); w.w = cvt_pk_bf16(v1[2], v1[3]); pre[ai][m][bj] = w;
                        s += (v0[0] * v0[0] + v0[1] * v0[1]) + (v0[2] * v0[2] + v0[3] * v0[3]) + (v1[0] * v1[0] + v1[1] * v1[1]) + (v1[2] * v1[2] + v1[3] * v1[3]); }
                    s += __shfl_xor(s, 16); s += __shfl_xor(s, 32); sq[ai][m] = s; }
            __builtin_amdgcn_sched_barrier(0);
#pragma unroll
            for (int ai = 0; ai < 2; ++ai)
#pragma unroll
                for (int m = 0; m < 4; ++m) {
#pragma unroll
                    for (int bj = 0; bj < 2; ++bj) *(u32x4*)(XH + off0 + (unsigned)((ai * HALF + m * 16) * 1024 + bj * HALF)) = pre[ai][m][bj];
                    if (fq == 0) __hip_atomic_fetch_add(ss + (off0 >> 10) + ai * HALF + m * 16, sq[ai][m], __ATOMIC_RELAXED, __HIP_MEMORY_SCOPE_AGENT); }
        }
    }
};

template <class Epi, class Sched, bool ALIGN_EPI = false, bool SP2 = false>
__device__ __forceinline__ void gemm_phase(PG8_LAS unsigned char* lds, const Gemm g, const Sched& S, const Epi& E) {
    int tid_ = threadIdx.x; asm volatile("" : "+v"(tid_));
    const int tid = tid_, wid = __builtin_amdgcn_readfirstlane(tid >> 6), lane = tid & 63, wr = wid >> 2, wc = wid & 3, fr = lane & 15, fq = lane >> 4;
    const int K = g.K, nt = K / BK;
    unsigned voffA[2], voffB[2];
#pragma unroll
    for (int i = 0; i < 2; ++i) { int R, C; stage_rc(tid * 16 + i * 8192, R, C); const int Rb = Epi::PERM ? ((R & ~31) + perm32(R & 31)) : R;
        voffA[i] = (unsigned)(R * K + C) * 2u; voffB[i] = (unsigned)(Rb * K + C) * 2u; }
    const size_t kstep = (size_t)(BK * 2);
    const size_t hstep = (size_t)HALF * K * 2;
    const size_t tstep = 2 * hstep;
    const unsigned ldsw = (unsigned)wid * 1024u;
    const int aoff = lds_byte(wr * 64 + fr, fq * 8), boff = lds_byte(wc * 32 + fr, fq * 8);
#define PG8_SA(b, h) (((b) * 2 + (h)) * HTB)
#define PG8_SB(b, h) ((4 + (b) * 2 + (h)) * HTB)
#define PG8_STAGE(bufoff, gbase, voff) do { _Pragma("unroll") for (int _i = 0; _i < 2; ++_i) \
        __builtin_amdgcn_global_load_lds((const unsigned*)((const char*)(gbase) + (voff)[_i]), (PG8_LAS unsigned*)(lds + (bufoff) + ldsw + _i * 8192), 16, 0, 0); } while (0)
#define PG8_LDA(dst, b, h) do { _Pragma("unroll") for (int m = 0; m < 4; ++m) _Pragma("unroll") for (int k = 0; k < 2; ++k) dst[m][k] = *(const PG8_LAS bf16x8*)(lds + PG8_SA(b, h) + aoff + m * 2048 + k * 1024); } while (0)
#define PG8_LDB(dst, b, h) do { _Pragma("unroll") for (int n = 0; n < 2; ++n) _Pragma("unroll") for (int k = 0; k < 2; ++k) dst[n][k] = *(const PG8_LAS bf16x8*)(lds + PG8_SB(b, h) + boff + n * 2048 + k * 1024); } while (0)
#define PG8_MMA(ai, bj, At, Bt) do { __builtin_amdgcn_s_setprio(1); _Pragma("unroll") for (int m = 0; m < 4; ++m) _Pragma("unroll") for (int n = 0; n < 2; ++n) _Pragma("unroll") for (int k = 0; k < 2; ++k) \
        acc[ai][bj][m][n] = __builtin_amdgcn_mfma_f32_16x16x32_bf16(Bt[n][k], At[m][k], acc[ai][bj][m][n], 0, 0, 0); __builtin_amdgcn_s_setprio(0); } while (0)
#define PG8_WAIT_V(n) asm volatile("s_waitcnt vmcnt(" #n ")" ::: "memory")
#define PG8_WAIT_L(n) asm volatile("s_waitcnt lgkmcnt(" #n ")" ::: "memory")
#define PG8_BAR __builtin_amdgcn_s_barrier()
#define PG8_SCHED __builtin_amdgcn_sched_barrier(0)
    Unit cur, nxt; int ui = 0;
    if (!S.next(0, cur)) return;
    f32x4 acc[2][2][4][2];
#pragma unroll
    for (int a = 0; a < 2; ++a)
#pragma unroll
        for (int b = 0; b < 2; ++b)
#pragma unroll
            for (int m = 0; m < 4; ++m)
#pragma unroll
                for (int n = 0; n < 2; ++n) acc[a][b][m][n] = (f32x4){0.f, 0.f, 0.f, 0.f};
    bf16x8 At[4][2], B0[2][2], B1[2][2];
    const char* cA = (const char*)g.A + (size_t)cur.pm * tstep; const char* cB = (const char*)g.Bt + (size_t)cur.pn * tstep;
    S.a_ready(cur);
    if constexpr (SP2) {
        PG8_STAGE(PG8_SB(0, 0), cB, voffB); PG8_STAGE(PG8_SB(0, 1), cB + hstep, voffB); PG8_STAGE(PG8_SA(0, 0), cA, voffA); PG8_STAGE(PG8_SA(0, 1), cA + hstep, voffA);
        if (wr == 1) PG8_BAR;
        PG8_WAIT_V(2); PG8_BAR;
        PG8_STAGE(PG8_SB(1, 0), cB + kstep, voffB); PG8_STAGE(PG8_SA(1, 0), cA + kstep, voffA); PG8_STAGE(PG8_SB(1, 1), cB + hstep + kstep, voffB);
        PG8_WAIT_V(6); PG8_BAR;
    } else {
        PG8_STAGE(PG8_SB(0, 0), cB, voffB); PG8_STAGE(PG8_SA(0, 0), cA, voffA); PG8_STAGE(PG8_SB(0, 1), cB + hstep, voffB); PG8_STAGE(PG8_SA(0, 1), cA + hstep, voffA);
        if (wr == 1) PG8_BAR;
        PG8_WAIT_V(4); PG8_BAR;
        PG8_STAGE(PG8_SB(1, 0), cB + kstep, voffB); PG8_STAGE(PG8_SA(1, 0), cA + kstep, voffA); PG8_STAGE(PG8_SB(1, 1), cB + hstep + kstep, voffB);
        PG8_WAIT_V(6); PG8_BAR;
    }
    for (;;) {
        const bool has_next = S.next(ui + 1, nxt);
        const char* nA = has_next ? (const char*)g.A + (size_t)nxt.pm * tstep : cA; const char* nB = has_next ? (const char*)g.Bt + (size_t)nxt.pn * tstep : cB;
        for (int t = 0; t < nt; t += 2) {
            const bool last = (t == nt - 2);
            const char* a1 = cA + (size_t)(t + 1) * kstep;
            const char* a2 = last ? nA : cA + (size_t)(t + 2) * kstep; const char* b2 = last ? nB : cB + (size_t)(t + 2) * kstep;
            const char* a3 = a2 + kstep; const char* b3 = b2 + kstep;
            if (last && has_next) S.a_ready(nxt);
            if constexpr (SP2) {
            PG8_LDB(B0, 0, 0); PG8_LDB(B1, 0, 1); PG8_SCHED; PG8_LDA(At, 0, 0); PG8_STAGE(PG8_SA(1, 1), a1 + hstep, voffA);
            PG8_WAIT_V(8); PG8_WAIT_L(0); PG8_BAR; PG8_MMA(0, 0, At, B0); PG8_MMA(0, 1, At, B1); PG8_BAR; PG8_SCHED;
            PG8_LDA(At, 0, 1); PG8_STAGE(PG8_SB(0, 0), b2, voffB); PG8_STAGE(PG8_SB(0, 1), b2 + hstep, voffB); PG8_STAGE(PG8_SA(0, 0), a2, voffA);
            PG8_WAIT_V(8); PG8_WAIT_L(0); PG8_BAR; PG8_MMA(1, 0, At, B0); PG8_MMA(1, 1, At, B1); PG8_BAR; PG8_SCHED;
            PG8_LDB(B0, 1, 0); PG8_LDB(B1, 1, 1); PG8_SCHED; PG8_LDA(At, 1, 0); PG8_STAGE(PG8_SA(0, 1), a2 + hstep, voffA);
            PG8_WAIT_V(8); PG8_WAIT_L(0); PG8_BAR; PG8_MMA(0, 0, At, B0); PG8_MMA(0, 1, At, B1); PG8_BAR; PG8_SCHED;
            PG8_LDA(At, 1, 1); PG8_STAGE(PG8_SB(1, 0), b3, voffB); PG8_STAGE(PG8_SB(1, 1), b3 + hstep, voffB); PG8_STAGE(PG8_SA(1, 0), a3, voffA);
            PG8_WAIT_V(8); PG8_WAIT_L(0); PG8_BAR; PG8_MMA(1, 0, At, B0); PG8_MMA(1, 1, At, B1); PG8_BAR; PG8_SCHED;
            } else {
            PG8_LDB(B0, 0, 0); PG8_SCHED; PG8_LDA(At, 0, 0); PG8_STAGE(PG8_SA(1, 1), a1 + hstep, voffA);
            PG8_WAIT_L(8); PG8_BAR; PG8_WAIT_L(0); PG8_MMA(0, 0, At, B0); PG8_BAR; PG8_SCHED;
            PG8_LDB(B1, 0, 1); PG8_STAGE(PG8_SB(0, 0), b2, voffB);
            PG8_BAR; PG8_WAIT_L(0); PG8_MMA(0, 1, At, B1); PG8_BAR;
            PG8_LDA(At, 0, 1); PG8_STAGE(PG8_SA(0, 0), a2, voffA);
            PG8_BAR; PG8_WAIT_L(0); PG8_MMA(1, 0, At, B0); PG8_BAR; PG8_SCHED;
            PG8_STAGE(PG8_SB(0, 1), b2 + hstep, voffB);
            PG8_WAIT_V(6); PG8_BAR; PG8_MMA(1, 1, At, B1); PG8_BAR;
            PG8_LDB(B0, 1, 0); PG8_SCHED; PG8_LDA(At, 1, 0); PG8_STAGE(PG8_SA(0, 1), a2 + hstep, voffA);
            PG8_WAIT_L(8); PG8_BAR; PG8_WAIT_L(0); PG8_MMA(0, 0, At, B0); PG8_BAR; PG8_SCHED;
            PG8_LDB(B1, 1, 1); PG8_STAGE(PG8_SB(1, 0), b3, voffB);
            PG8_BAR; PG8_WAIT_L(0); PG8_MMA(0, 1, At, B1); PG8_BAR;
            PG8_LDA(At, 1, 1); PG8_STAGE(PG8_SA(1, 0), a3, voffA);
            PG8_BAR; PG8_WAIT_L(0); PG8_MMA(1, 0, At, B0); PG8_BAR; PG8_SCHED;
            PG8_STAGE(PG8_SB(1, 1), b3 + hstep, voffB);
            PG8_WAIT_V(6); PG8_BAR; PG8_MMA(1, 1, At, B1); PG8_BAR;
            }
        }
        if constexpr (ALIGN_EPI) { if (wr == 0) PG8_BAR; }
        if constexpr (!Epi::AFTER_DRAIN) { E(acc, cur, wr, wc, fr, fq); S.done(cur); }
        if (!has_next) break;
#pragma unroll
        for (int a = 0; a < 2; ++a)
#pragma unroll
            for (int b = 0; b < 2; ++b)
#pragma unroll
                for (int m = 0; m < 4; ++m)
#pragma unroll
                    for (int n = 0; n < 2; ++n) acc[a][b][m][n] = (f32x4){0.f, 0.f, 0.f, 0.f};
        cur = nxt; cA = nA; cB = nB; ++ui;
        if constexpr (ALIGN_EPI) { if (wr == 1) PG8_BAR; }
    }
    PG8_WAIT_V(0);
    if constexpr (!ALIGN_EPI) { if (wr == 0) PG8_BAR; }
    PG8_BAR;
    if constexpr (Epi::AFTER_DRAIN) { E.fused(acc, cur, wr, wc, fr, fq, lds, wid, lane); S.done(cur); }
#undef PG8_SA
#undef PG8_SB
#undef PG8_STAGE
#undef PG8_LDA
#undef PG8_LDB
#undef PG8_MMA
#undef PG8_WAIT_V
#undef PG8_WAIT_L
#undef PG8_BAR
#undef PG8_SCHED
}
}
constexpr int NB = 8, SEQ = 4096, T = NB * SEQ, DM = 1024, DFF = 2816, NMEM = 256, MROWS = NB * NMEM;
constexpr float C2 = 0.125f * 1.4426950408889634f;
constexpr float SB_EXIT = -160.0f;
constexpr size_t MiB = 1u << 20;
constexpr size_t WS_W_AIN = 1 * MiB, WS_W_AOUT = 3 * MiB, WS_W_AGU = 5 * MiB, WS_W_ADOWN = 16 * MiB, WS_W_MKV = 22 * MiB, WS_W_KQV = 24 * MiB,
                 WS_W_BOUT = 30 * MiB, WS_W_BGU = 32 * MiB, WS_W_BDOWN = 43 * MiB, WS_W_GRP = 49 * MiB, WS_MEMN = 50 * MiB, WS_MEMK = 54 * MiB, WS_MEMVT = 56 * MiB,
                 WS_SS = 58 * MiB, WS_XR = 64 * MiB, WS_XB = 192 * MiB, WS_PROJ = 256 * MiB, WS_MIX = 320 * MiB, WS_KB = 384 * MiB, WS_VT = 432 * MiB, WS_H = 256 * MiB, WS_END = 482 * MiB;
static_assert(WS_H + (size_t)T * DFF * 2 <= WS_VT, "h overlays PROJ|MIX|KB only");

namespace mix {
#define DI __device__ __forceinline__
typedef unsigned short bf16_t;
typedef short bf16x8 __attribute__((ext_vector_type(8)));
typedef float f32x16 __attribute__((ext_vector_type(16)));
typedef float f32x4 __attribute__((ext_vector_type(4)));
typedef unsigned u32x4 __attribute__((ext_vector_type(4)));
#define MFMA32(a, b, c) __builtin_amdgcn_mfma_f32_32x32x16_bf16((a), (b), (c), 0, 0, 0)
DI int pi32(int i) { return (i & 0x13) | ((i & 4) << 1) | ((i & 8) >> 1); }
DI unsigned pk2(float lo, float hi) { return pg8::cvt_pk_bf16(lo, hi); }
DI bf16x8 pack8(float a0, float a1, float a2, float a3, float a4, float a5, float a6, float a7) { u32x4 w; w.x = pk2(a0, a1); w.y = pk2(a2, a3); w.z = pk2(a4, a5); w.w = pk2(a6, a7); return __builtin_bit_cast(bf16x8, w); }
#define PACK8(P, B) pack8(P[(B)], P[(B) + 1], P[(B) + 2], P[(B) + 3], P[(B) + 4], P[(B) + 5], P[(B) + 6], P[(B) + 7])
DI bf16x8 ld8(const bf16_t* p) { return *(const bf16x8*)p; }
DI bf16x8 ldo(const void* base, unsigned off) { return *(const bf16x8*)((const char*)base + off); }
DI void sto8(void* base, unsigned off, const f32x16& o, int b) { u32x4 w; w.x = pk2(o[b], o[b + 1]); w.y = pk2(o[b + 2], o[b + 3]); w.z = pk2(o[b + 4], o[b + 5]); w.w = pk2(o[b + 6], o[b + 7]); *(u32x4*)((char*)base + off) = w; }
DI void halves(float v, float& lo, float& hi) { auto rr = __builtin_amdgcn_permlane32_swap(__float_as_uint(v), __float_as_uint(v), false, false); lo = __uint_as_float(rr[0]); hi = __uint_as_float(rr[1]); }
DI void store_o8(bf16_t* p, const f32x16& o, int b) { u32x4 w; w.x = pk2(o[b], o[b + 1]); w.y = pk2(o[b + 2], o[b + 3]); w.z = pk2(o[b + 4], o[b + 5]); w.w = pk2(o[b + 6], o[b + 7]); *(u32x4*)p = w; }

template <bool MASKED> DI void sb_group(f32x16& P, const int B, const int keyb, const int t, float& gt) {
    float run = 1.f;
#pragma unroll
    for (int i = 7; i >= 0; --i) {
        const float e = __builtin_amdgcn_exp2f(__builtin_amdgcn_fmed3f(-P[B + i], -126.f, 126.f));
        float beta = __builtin_amdgcn_rcpf(1.0f + e), nb = e * beta;
        if (MASKED) { const bool valid = (keyb + i) < t; beta = valid ? beta : 0.f; nb = valid ? nb : 1.f; }
        P[B + i] = beta * run;
        run *= nb;
    }
    gt = run;
}
template <bool MASKED> DI void sb_tile(f32x16& p0, f32x16& p1, float& carry, const int key0, const int t, const int hh) {
    float g0, g1, g2, g3;
    sb_group<MASKED>(p0, 0, key0 + 8 * hh, t, g0); sb_group<MASKED>(p0, 8, key0 + 16 + 8 * hh, t, g1);
    sb_group<MASKED>(p1, 0, key0 + 32 + 8 * hh, t, g2); sb_group<MASKED>(p1, 8, key0 + 48 + 8 * hh, t, g3);
    float l0, h0, l1, h1, l2, h2, l3, h3; halves(g0, l0, h0); halves(g1, l1, h1); halves(g2, l2, h2); halves(g3, l3, h3);
    const float t3 = l3 * h3, t2 = l2 * h2, t1 = l1 * h1, t0 = l0 * h0;
    const float c3 = __builtin_amdgcn_exp2f(carry), c2 = c3 * t3, c1 = c2 * t2, c0 = c1 * t1;
    const float o0 = hh ? c0 : c0 * h0, o1 = hh ? c1 : c1 * h1, o2 = hh ? c2 : c2 * h2, o3 = hh ? c3 : c3 * h3;
#pragma unroll
    for (int i = 0; i < 8; ++i) { p0[i] *= o0; p0[8 + i] *= o1; p1[i] *= o2; p1[8 + i] *= o3; }
    carry += (__builtin_amdgcn_logf(t3) + __builtin_amdgcn_logf(t2)) + (__builtin_amdgcn_logf(t1) + __builtin_amdgcn_logf(t0));
}
template <bool MASKED> DI bool sb_step(bf16x8 (&kf)[2][4], const bf16x8 (&qf)[4], f32x16& o0, f32x16& o1, float& carry, const int j, const int t, const int hh,
                                       const bf16_t* ku, const bf16_t* vu, const unsigned loff) {
    const int key0 = j * 64;
    f32x16 p0 = {}, p1 = {};
#pragma unroll
    for (int s = 0; s < 4; ++s) { p0 = MFMA32(kf[0][s], qf[s], p0); p1 = MFMA32(kf[1][s], qf[s], p1); }
    bf16x8 vf[2][4];
#pragma unroll
    for (int dt = 0; dt < 2; ++dt)
#pragma unroll
        for (int s = 0; s < 4; ++s) vf[dt][s] = ldo(vu + (size_t)j * 4096, loff + (dt * 4 + s) * 1024);
    if (j > 0) {
#pragma unroll
        for (int hf = 0; hf < 2; ++hf)
#pragma unroll
            for (int s = 0; s < 4; ++s) kf[hf][s] = ldo(ku + (size_t)(j - 1) * 4096, loff + (hf * 4 + s) * 1024);
    }
    sb_tile<MASKED>(p0, p1, carry, key0, t, hh);
    const bf16x8 w0 = PACK8(p0, 0), w1 = PACK8(p0, 8), w2 = PACK8(p1, 0), w3 = PACK8(p1, 8);
    o0 = MFMA32(vf[0][0], w0, o0); o1 = MFMA32(vf[1][0], w0, o1);
    o0 = MFMA32(vf[0][1], w1, o0); o1 = MFMA32(vf[1][1], w1, o1);
    o0 = MFMA32(vf[0][2], w2, o0); o1 = MFMA32(vf[1][2], w2, o1);
    o0 = MFMA32(vf[0][3], w3, o0); o1 = MFMA32(vf[1][3], w3, o1);
    return j == 0 || __all(carry < SB_EXIT);
}
DI void sb_unit(const bf16_t* __restrict__ Q, const bf16_t* __restrict__ Kb, const bf16_t* __restrict__ VT, bf16_t* __restrict__ O, const int b, const int h, const int q0, int lane) {
    asm volatile("" : "+v"(lane));
    const int li = lane & 31, hh = lane >> 5, t = q0 + li;
    const size_t trow = (size_t)b * SEQ;
    const bf16_t* qu = Q + (trow + q0) * 1024 + h * 64;
    const bf16_t* ku = Kb + (size_t)(b * 12 + h) * (SEQ * 64);
    const bf16_t* vu = VT + (size_t)(b * 12 + h) * (SEQ * 64);
    bf16_t* ou = O + (trow + q0) * 1024 + h * 64;
    const unsigned qoff = (unsigned)(li * 1024 + hh * 8) * 2u, loff = (unsigned)lane * 16u;
    bf16x8 qf[4];
#pragma unroll
    for (int s = 0; s < 4; ++s) qf[s] = __builtin_nontemporal_load((const bf16x8*)((const char*)qu + (qoff + 32 * s)));
    f32x16 o0 = {}, o1 = {}; float carry = 0.f;
    int j = (q0 + 30) >> 6;
    bf16x8 kf[2][4];
#pragma unroll
    for (int hf = 0; hf < 2; ++hf)
#pragma unroll
        for (int s = 0; s < 4; ++s) kf[hf][s] = ldo(ku + (size_t)j * 4096, loff + (hf * 4 + s) * 1024);
    bool done = sb_step<true>(kf, qf, o0, o1, carry, j, t, hh, ku, vu, loff);
    while (!done) { --j; done = sb_step<false>(kf, qf, o0, o1, carry, j, t, hh, ku, vu, loff); }
    sto8(ou, qoff, o0, 0); sto8(ou, qoff + 32, o0, 8); sto8(ou, qoff + 64, o1, 0); sto8(ou, qoff + 96, o1, 8);
}
DI void memkv_unit(const bf16_t* __restrict__ MNF, const bf16_t* __restrict__ WF, bf16_t* __restrict__ MK, bf16_t* __restrict__ MVT, const int u, int lane) {
    asm volatile("" : "+v"(lane));
    const int li = lane & 31, hh = lane >> 5;
    const bool isv = u >= 1024; const int v = u & 1023, tt = v & 63, dt = (v >> 6) & 1, hd = v >> 7;
    const bf16_t* wt = WF + (size_t)(((isv ? 16 : 0) + hd * 2 + dt) * 64) * 512;
    const bf16_t* mt = MNF + (size_t)(tt * 64) * 512;
    const unsigned loff = (unsigned)lane * 16u, poff = (unsigned)(pi32(li) + 32 * hh) * 16u;
    const bf16_t* pa = isv ? mt : wt; const bf16_t* pb = isv ? wt : mt; const unsigned oa = isv ? poff : loff;
    f32x16 acc = {}, acc2 = {};
#pragma unroll 1
    for (int s0 = 0; s0 < 64; s0 += 16) {
        bf16x8 fa[16], fb[16];
#pragma unroll
        for (int s = 0; s < 16; ++s) { fa[s] = ldo(pa + (s0 + s) * 512, oa); fb[s] = ldo(pb + (s0 + s) * 512, loff); }
#pragma unroll
        for (int s = 0; s < 16; s += 2) { acc = MFMA32(fa[s], fb[s], acc); acc2 = MFMA32(fa[s + 1], fb[s + 1], acc2); }
    }
    acc = acc + acc2;
    const int tok0 = tt * 32, b = tok0 >> 8, key0 = tok0 & 255, tile = key0 >> 6;
    if (!isv) {
        bf16_t* o = MK + ((size_t)(((b * 8 + hd) * 4 + tile) * 8 + ((key0 >> 5) & 1) * 4 + dt * 2)) * 512;
        sto8(o, poff, acc, 0); sto8(o + 512, poff, acc, 8);
    } else {
        bf16_t* o = MVT + ((size_t)(((b * 8 + hd) * 4 + tile) * 8 + dt * 4 + ((key0 >> 4) & 3))) * 512;
        sto8(o, loff, acc, 0); sto8(o + 512, loff, acc, 8);
    }
}
DI void mem_unit(const bf16_t* __restrict__ Q, const int ldq, const bf16_t* __restrict__ MK, const bf16_t* __restrict__ MVT, bf16_t* __restrict__ O, const int row0, const int hm, const int lay, int lane) {
    asm volatile("" : "+v"(lane));
    const int li = lane & 31, hh = lane >> 5, b = row0 / SEQ;
    const bf16_t* qu = Q + (size_t)row0 * ldq + hm * 64;
    const bf16_t* ku = MK + (size_t)((b * 8 + lay * 4 + hm) * 4) * 4096;
    const bf16_t* vu = MVT + (size_t)((b * 8 + lay * 4 + hm) * 4) * 4096;
    bf16_t* ou = O + (size_t)row0 * 1024 + 768 + hm * 64;
    const unsigned qoff = (unsigned)(li * ldq + hh * 8) * 2u, ooff = (unsigned)(li * 1024 + hh * 8) * 2u, loff = (unsigned)lane * 16u;
    bf16x8 qf[4];
#pragma unroll
    for (int s = 0; s < 4; ++s) qf[s] = __builtin_nontemporal_load((const bf16x8*)((const char*)qu + (qoff + 32 * s)));
    f32x16 o0 = {}, o1 = {}; float mrun = -1e30f, lsum = 0.f;
    bf16x8 kf[2][4], vf[2][4];
#pragma unroll
    for (int hf = 0; hf < 2; ++hf)
#pragma unroll
        for (int s = 0; s < 4; ++s) kf[hf][s] = ldo(ku, loff + (hf * 4 + s) * 1024);
#pragma unroll 1
    for (int c = 0; c < 4; ++c) {
        bf16x8 kn[2][4];
#pragma unroll
        for (int dt = 0; dt < 2; ++dt)
#pragma unroll
            for (int s = 0; s < 4; ++s) vf[dt][s] = ldo(vu + c * 4096, loff + (dt * 4 + s) * 1024);
        { const int cn = c < 3 ? c + 1 : 3;
#pragma unroll
            for (int hf = 0; hf < 2; ++hf)
#pragma unroll
                for (int s = 0; s < 4; ++s) kn[hf][s] = ldo(ku + cn * 4096, loff + (hf * 4 + s) * 1024);
        }
        f32x16 p0 = {}, p1 = {};
#pragma unroll
        for (int s = 0; s < 4; ++s) { p0 = MFMA32(kf[0][s], qf[s], p0); p1 = MFMA32(kf[1][s], qf[s], p1); }
        float mx = __builtin_fmaxf(p0[0], p1[0]);
#pragma unroll
        for (int i = 1; i < 16; ++i) mx = __builtin_fmaxf(mx, __builtin_fmaxf(p0[i], p1[i]));
        float ml, mh; halves(mx, ml, mh); mx = __builtin_fmaxf(ml, mh);
        const float mnew = __builtin_fmaxf(mrun, mx), alpha = __builtin_amdgcn_exp2f(mrun - mnew); mrun = mnew;
        float ps = 0.f;
#pragma unroll
        for (int i = 0; i < 16; ++i) { p0[i] = __builtin_amdgcn_exp2f(p0[i] - mnew); p1[i] = __builtin_amdgcn_exp2f(p1[i] - mnew); ps += p0[i] + p1[i]; }
        lsum = lsum * alpha + ps;
#pragma unroll
        for (int i = 0; i < 16; ++i) { o0[i] *= alpha; o1[i] *= alpha; }
        const bf16x8 w0 = PACK8(p0, 0), w1 = PACK8(p0, 8), w2 = PACK8(p1, 0), w3 = PACK8(p1, 8);
        o0 = MFMA32(vf[0][0], w0, o0); o1 = MFMA32(vf[1][0], w0, o1);
        o0 = MFMA32(vf[0][1], w1, o0); o1 = MFMA32(vf[1][1], w1, o1);
        o0 = MFMA32(vf[0][2], w2, o0); o1 = MFMA32(vf[1][2], w2, o1);
        o0 = MFMA32(vf[0][3], w3, o0); o1 = MFMA32(vf[1][3], w3, o1);
#pragma unroll
        for (int x = 0; x < 2; ++x)
#pragma unroll
            for (int s = 0; s < 4; ++s) kf[x][s] = kn[x][s];
    }
    float ll, lh; halves(lsum, ll, lh); const float inv = 1.0f / (ll + lh);
#pragma unroll
    for (int i = 0; i < 16; ++i) { o0[i] *= inv; o1[i] *= inv; }
    sto8(ou, ooff, o0, 0); sto8(ou, ooff + 32, o0, 8); sto8(ou, ooff + 64, o1, 0); sto8(ou, ooff + 96, o1, 8);
}
template <int GI> DI void pool_unit_t(const bf16_t* __restrict__ U, const bf16_t* __restrict__ WG, bf16_t* __restrict__ O, const int row0, int lane) {
    asm volatile("" : "+v"(lane));
    constexpr int w = 2 << GI;
    const int li = lane & 31, hh = lane >> 5, pos = (row0 & (SEQ - 1)) + li;
    const int cnt = (pos + 1) < w ? (pos + 1) : w; const float rc = 1.0f / (float)cnt;
    const char* ub = (const char*)(U + ((size_t)(row0 >> 5) * 48 + GI * 12) * 512) - 48 * 1024;
    bf16_t* ou = O + (size_t)row0 * 1024 + GI * 192;
    const unsigned ooff = (unsigned)(li * 1024 + hh * 8) * 2u, loff = (unsigned)lane * 16u;
    const float nextra = (float)((w - 1 - pos) > 0 ? (w - 1 - pos) : 0);
    f32x16 o[6];
#pragma unroll
    for (int d = 0; d < 6; ++d) o[d] = f32x16{};
#pragma unroll 1
    for (int s = 0; s < 12; ++s) {
        const u32x4 v0 = *(const u32x4*)(ub + (unsigned)(48 * 1024 + s * 1024) + loff);
        bf16x8 wf[6];
#pragma unroll
        for (int d = 0; d < 6; ++d) wf[d] = ldo(WG, loff + (d * 12 + s) * 1024);
        float cur[8], sum[8], last[8];
#pragma unroll
        for (int e = 0; e < 4; ++e) { cur[2 * e] = __uint_as_float(v0[e] << 16); cur[2 * e + 1] = __uint_as_float(v0[e] & 0xffff0000u); sum[2 * e] = cur[2 * e]; sum[2 * e + 1] = cur[2 * e + 1]; }
#pragma unroll
        for (int i0 = 1; i0 < w; i0 += 8) {
            constexpr int NBATCH = 8;
            u32x4 v[NBATCH];
#pragma unroll
            for (int i = 0; i < NBATCH; ++i) if (i0 + i < w) { const int ie = (i0 + i) < pos ? (i0 + i) : pos, rr = li - ie;
                v[i] = *(const u32x4*)(ub + ((unsigned)(((rr >> 5) + 1) * (48 * 1024) + s * 1024) + (unsigned)(((rr & 31) + 32 * hh) * 16))); }
#pragma unroll
            for (int i = 0; i < NBATCH; ++i) if (i0 + i < w) {
#pragma unroll
                for (int e = 0; e < 4; ++e) { const float lo = __uint_as_float(v[i][e] << 16), hi = __uint_as_float(v[i][e] & 0xffff0000u); sum[2 * e] += lo; sum[2 * e + 1] += hi; if (i0 + i == w - 1) { last[2 * e] = lo; last[2 * e + 1] = hi; } } }
        }
        const bf16x8 pf = pack8((sum[0] - nextra * last[0]) * rc - cur[0], (sum[1] - nextra * last[1]) * rc - cur[1], (sum[2] - nextra * last[2]) * rc - cur[2], (sum[3] - nextra * last[3]) * rc - cur[3],
                                (sum[4] - nextra * last[4]) * rc - cur[4], (sum[5] - nextra * last[5]) * rc - cur[5], (sum[6] - nextra * last[6]) * rc - cur[6], (sum[7] - nextra * last[7]) * rc - cur[7]);
#pragma unroll
        for (int d = 0; d < 6; ++d) o[d] = MFMA32(wf[d], pf, o[d]);
    }
#pragma unroll
    for (int d = 0; d < 6; ++d) { sto8(ou, ooff + d * 64, o[d], 0); sto8(ou, ooff + d * 64 + 32, o[d], 8); }
}
DI void pool_unit(const bf16_t* __restrict__ U, const bf16_t* __restrict__ WG, bf16_t* __restrict__ O, const int row0, const int g, const int lane) {
    if (g == 0) pool_unit_t<0>(U, WG, O, row0, lane); else if (g == 1) pool_unit_t<1>(U, WG, O, row0, lane); else if (g == 2) pool_unit_t<2>(U, WG, O, row0, lane); else pool_unit_t<3>(U, WG, O, row0, lane);
}
}
#define LAS __attribute__((address_space(3)))
typedef unsigned short bf16;
typedef unsigned v4u __attribute__((ext_vector_type(4)));
typedef float f32x4 __attribute__((ext_vector_type(4)));
__device__ __forceinline__ float wave_sum(float v) {
#pragma unroll
    for (int o = 1; o < 64; o <<= 1) v += __shfl_xor(v, o);
    return v;
}
__device__ __forceinline__ void tr_item(const float* __restrict__ W, int N, int k0, int n0, bf16* dst, int Kld, const float* gk, const float* cn, LAS float* scr, int lane, bf16* fragbase = nullptr, int fragkb = 12, int fragrow0 = 0) {
    const int c4 = (lane & 15) * 4, kr = lane >> 4;
    f32x4 cs = {1.f, 1.f, 1.f, 1.f}; if (cn) cs = *(const f32x4*)(cn + n0 + c4);
    const float* wp = W + (size_t)(k0 + kr) * N + n0 + c4;
    f32x4 v[16];
#pragma unroll
    for (int i = 0; i < 16; ++i) v[i] = __builtin_nontemporal_load((const f32x4*)(wp + (size_t)(4 * i) * N));
#pragma unroll
    for (int i = 0; i < 16; ++i) { const int kk = 4 * i + kr; f32x4 x = v[i] * cs; if (gk) x = x * gk[k0 + kk];
        LAS float* d = scr + kk * 65 + c4; d[0] = x[0]; d[1] = x[1]; d[2] = x[2]; d[3] = x[3]; }
    asm volatile("s_waitcnt lgkmcnt(0)" ::: "memory");
    const int c = lane & 7;
#pragma unroll
    for (int j = 0; j < 8; ++j) { const int n = (lane >> 3) + 8 * j; const LAS float* s = scr + (8 * c) * 65 + n;
        v4u o; o.x = pg8::cvt_pk_bf16(s[0 * 65], s[1 * 65]); o.y = pg8::cvt_pk_bf16(s[2 * 65], s[3 * 65]); o.z = pg8::cvt_pk_bf16(s[4 * 65], s[5 * 65]); o.w = pg8::cvt_pk_bf16(s[6 * 65], s[7 * 65]);
        if (fragbase) { const int ng = fragrow0 + n, kg = k0 + 8 * c, ni = ng & 31, pn = (ni & 0x13) | ((ni & 4) << 1) | ((ni & 8) >> 1);
            *(v4u*)(fragbase + ((size_t)(ng >> 5) * fragkb + (kg >> 4)) * 512 + (pn + 32 * ((kg >> 3) & 1)) * 8) = o; }
        else *(v4u*)(dst + (size_t)n * Kld + 8 * c) = o; }
    asm volatile("s_waitcnt lgkmcnt(0)" ::: "memory");
}
__device__ __forceinline__ int rowmap(int mode, int n0) {
    switch (mode) {
        case 1: return n0 < 256 ? n0 : 512 + (n0 - 256);
        case 2: return n0 < 256 ? 256 + n0 : 768 + (n0 - 256);
        case 3: { const int f = n0 < DFF ? n0 : n0 - DFF; return (f / 128) * 256 + (n0 < DFF ? 0 : 128) + (f % 128); }
        case 4: return n0 < 768 ? n0 : n0 + 1024;
        case 5: return 768 + n0;
        default: return n0;
    }
}
#define XB_TMO      128
#define XB_XCNT(j)  (256  + 64 * (j))
#define XB_XSUB(j)  (1280 + 64 * (j))
#define XB_XGEN(j)  (2304 + 64 * (j))
#define XB_TOP      3328
#define XB_TOPGEN   3392
#define XCD_BAR_WORDS 3456
#define XB_SPIN_CAP (1u << 18)

__device__ __forceinline__ unsigned xb_ld(unsigned* p)              { return __hip_atomic_load(p, __ATOMIC_RELAXED, __HIP_MEMORY_SCOPE_AGENT); }
__device__ __forceinline__ unsigned xb_add(unsigned* p, unsigned v) { return __hip_atomic_fetch_add(p, v, __ATOMIC_RELAXED, __HIP_MEMORY_SCOPE_AGENT); }
__device__ __forceinline__ unsigned xb_xcc_id() { return (unsigned)__builtin_amdgcn_s_getreg((3 << 11) | 20) & 0xFu; }
#define XB_SPIN(cond, bar) do { unsigned _sp = 0; while (cond) { __builtin_amdgcn_s_sleep(1); \
    if ((++_sp & 255u) == 0u) { if (xb_ld(&(bar)[XB_TMO])) break; if (_sp > XB_SPIN_CAP) { atomicAdd(&(bar)[XB_TMO], 1u); break; } } } } while (0)

struct XcdBarrier {
    unsigned* bar; unsigned x;
    volatile LAS unsigned* st;
};

__device__ __forceinline__ XcdBarrier xcd_barrier_post(unsigned* bar, volatile LAS unsigned* st) {
    XcdBarrier b; b.bar = bar; b.x = xb_xcc_id(); b.st = st;
    if (threadIdx.x == 0) (void)xb_add(&bar[XB_XCNT(b.x)], 1u);
    return b;
}
__device__ __forceinline__ void xcd_barrier_complete(unsigned* bar, unsigned x, unsigned& nloc, unsigned& nx) {
    const unsigned G = gridDim.x * gridDim.y * gridDim.z;
    unsigned sum, cnt, mine, sp = 0u;
    for (;;) {
        sum = 0u; cnt = 0u; mine = 0u;
#pragma unroll
        for (unsigned j = 0; j < 16; ++j) { const unsigned c = xb_ld(&bar[XB_XCNT(j)]); sum += c; cnt += (c > 0u) ? 1u : 0u; mine = (j == x) ? c : mine; }
        if (sum == G) break;
        __builtin_amdgcn_s_sleep(1);
        if ((++sp & 255u) == 0u) { if (xb_ld(&bar[XB_TMO])) break; if (sp > XB_SPIN_CAP) { atomicAdd(&bar[XB_TMO], 1u); break; } }
    }
    nloc = mine > 0u ? mine : 1u; nx = cnt > 0u ? cnt : 1u;
}

__device__ __forceinline__ void xcd_barrier(const XcdBarrier& b) {
    asm volatile("s_waitcnt vmcnt(0)" ::: "memory");
    __syncthreads();
    if (threadIdx.x == 0) {
        unsigned* bar = b.bar;
        __builtin_amdgcn_s_waitcnt(0);
        unsigned nloc = b.st[0], nx = b.st[1];
        if (nloc == 0u) { xcd_barrier_complete(bar, b.x, nloc, nx); b.st[0] = nloc; b.st[1] = nx; }
        const unsigned old = xb_add(&bar[XB_XSUB(b.x)], 1u);
        const unsigned gen = old / nloc;
        if (old + 1u == (gen + 1u) * nloc) {
            __builtin_amdgcn_fence(__ATOMIC_RELEASE, "agent");
            asm volatile("s_waitcnt vmcnt(0)" ::: "memory");
            const unsigned og = xb_add(&bar[XB_TOP], 1u);
            const unsigned tg = og / nx;
            if (og + 1u == (tg + 1u) * nx) xb_add(&bar[XB_TOPGEN], 1u);
            else XB_SPIN(xb_ld(&bar[XB_TOPGEN]) == tg, bar);
            __builtin_amdgcn_fence(__ATOMIC_ACQUIRE, "agent");
            xb_add(&bar[XB_XGEN(b.x)], 1u);
            asm volatile("s_waitcnt vmcnt(0)" ::: "memory");
        } else {
            XB_SPIN(xb_ld(&bar[XB_XGEN(b.x)]) == gen, bar);
            __builtin_amdgcn_fence(__ATOMIC_ACQUIRE, "agent");
            asm volatile("s_waitcnt vmcnt(0)" ::: "memory");
        }
    }
    __syncthreads();
}

#ifndef REP_PRO
#define REP_PRO 1
#endif
#ifndef REP_MIXA
#define REP_MIXA 1
#endif
#ifndef REP_MIXB
#define REP_MIXB 1
#endif
#ifndef REP_FIN
#define REP_FIN 1
#endif
#ifndef REP_UP
#define REP_UP 1
#endif
struct Args { const float* in[22]; float* out; unsigned char* ws; };

__global__ void __launch_bounds__(512, 2) yoco_fwd(Args a) {
    extern __shared__ __attribute__((aligned(16))) unsigned char lds_raw[];
    cg::grid_group grid = cg::this_grid();
    LAS unsigned char* lds = (LAS unsigned char*)lds_raw;
    const int tid = threadIdx.x, wave = __builtin_amdgcn_readfirstlane(tid >> 6);
    const int G = gridDim.x, bx = blockIdx.x, vcu = (G % 8 == 0) ? (bx % 8) * (G / 8) + bx / 8 : bx;
    const int gw = vcu * 8 + wave, NGW = G * 8;
    volatile LAS unsigned* MISC = (volatile LAS unsigned*)(lds + 134144);
    if (tid < 16) MISC[tid] = 0u;
    __syncthreads();
    const XcdBarrier xbar = xcd_barrier_post((unsigned*)a.ws, MISC + 8);
    if (a.out == nullptr) grid.sync();
#define GSYNC() xcd_barrier(xbar)
#define WSP(T_, off) ((T_*)(a.ws + (off)))
#define W_AIN WSP(bf16, WS_W_AIN)
#define W_AOUT WSP(bf16, WS_W_AOUT)
#define W_AGU WSP(bf16, WS_W_AGU)
#define W_ADOWN WSP(bf16, WS_W_ADOWN)
#define W_MKV WSP(bf16, WS_W_MKV)
#define W_KQV WSP(bf16, WS_W_KQV)
#define W_BOUT WSP(bf16, WS_W_BOUT)
#define W_BGU WSP(bf16, WS_W_BGU)
#define W_BDOWN WSP(bf16, WS_W_BDOWN)
#define W_GRP WSP(bf16, WS_W_GRP)
#define MEMN WSP(bf16, WS_MEMN)
#define MEMK WSP(bf16, WS_MEMK)
#define MEMVT WSP(bf16, WS_MEMVT)
#define SS WSP(float, WS_SS)
#define XB WSP(bf16, WS_XB)
#define PROJ WSP(bf16, WS_PROJ)
#define MIX WSP(bf16, WS_MIX)
#define QMA (PROJ + (size_t)T * 768)
#define KB WSP(bf16, WS_KB)
#define VT WSP(bf16, WS_VT)
#define HB WSP(bf16, WS_H)
#define GEMM_SCALE(gA, gB, gM, gN, gK, e0, e1, ld0, ld1, csplit, sc1, rss, css, vtb) do { pg8::Gemm g{gA, gB, gM, gN, gK}; pg8::StaticOrder S; S.init(gM, gN, G, bx); \
        pg8::EpiScale E{e0, e1, rss, css, ld0, ld1, csplit, sc1, vtb, 12, 12}; pg8::gemm_phase<pg8::EpiScale, pg8::StaticOrder, true, true>(lds, g, S, E); } while (0)
#define GEMM_SWIGLU(gA, gB, rss) do { pg8::Gemm g{gA, gB, T, 2 * DFF, 1024}; pg8::StaticOrder S; S.init(T, 2 * DFF, G, bx); \
        pg8::EpiSwiglu E{HB, rss, DFF}; pg8::gemm_phase<pg8::EpiSwiglu, pg8::StaticOrder, true, true>(lds, g, S, E); } while (0)
#define GEMM_RESID(F32B, gA, gB, gK, rbase, ssout) do { pg8::Gemm g{gA, gB, T, 1024, gK}; pg8::StaticOrder S; S.init(T, 1024, G, bx); \
        pg8::EpiResid<F32B> E{rbase, XB, ssout}; pg8::gemm_phase<pg8::EpiResid<F32B>, pg8::StaticOrder, true, true>(lds, g, S, E); } while (0)
#if REP_PRO > 1
    for (int rep = 0; rep < REP_PRO; ++rep)
#endif
    {
            int lane; asm volatile("v_mbcnt_lo_u32_b32 %0, -1, 0\n\tv_mbcnt_hi_u32_b32 %0, -1, %0" : "=v"(lane));
            LAS float* scr = (LAS float*)(lds + wave * 16640);
            constexpr int NITEMS = 256 + 36 + 2 * 128 + 2 * 256 + 2 * 1408 + 2 * 704 + 384 + 256;
            for (int it = gw; it < NITEMS; it += NGW) {
                int r = it; const float* W; const float* gk = nullptr; const float* cn = nullptr; bf16* WT; bf16* frag = nullptr; int fragkb = 12; int K = 1024, N = 1024, mode = 0;
                if (r < 256) { W = a.in[4]; gk = a.in[3]; WT = W_AIN; }
                else if ((r -= 256) < 36) { const int gi = r / 9; r -= gi * 9; W = a.in[5] + gi * 36864; cn = a.in[6] + gi * 192; WT = W_GRP + gi * 36864; frag = WT; K = 192; N = 192; }
                else if ((r -= 36) < 128) { W = a.in[7]; gk = a.in[2]; WT = W_MKV; frag = W_MKV; fragkb = 64; N = 512; mode = 1; }
                else if ((r -= 128) < 128) { W = a.in[16]; gk = a.in[2]; WT = W_MKV; frag = W_MKV; fragkb = 64; N = 512; mode = 2; }
                else if ((r -= 128) < 256) { W = a.in[8]; WT = W_AOUT; }
                else if ((r -= 256) < 256) { W = a.in[17]; WT = W_BOUT; }
                else if ((r -= 256) < 1408) { W = a.in[10]; gk = a.in[9]; WT = W_AGU; N = 2 * DFF; mode = 3; }
                else if ((r -= 1408) < 1408) { W = a.in[19]; gk = a.in[18]; WT = W_BGU; N = 2 * DFF; mode = 3; }
                else if ((r -= 1408) < 704) { W = a.in[11]; WT = W_ADOWN; K = DFF; }
                else if ((r -= 704) < 704) { W = a.in[20]; WT = W_BDOWN; K = DFF; }
                else if ((r -= 704) < 384) { W = a.in[13]; gk = a.in[12]; WT = W_KQV; N = 1536; mode = 4; }
                else { r -= 384; W = a.in[15]; gk = a.in[14]; WT = W_KQV; mode = 5; }
                const int nblk = N / 64, k0 = 64 * (r / nblk), n0 = 64 * (r % nblk);
                tr_item(W, N, k0, n0, WT + (size_t)rowmap(mode, n0) * K + k0, K, gk, cn, scr, lane, frag, fragkb, frag == W_MKV ? rowmap(mode, n0) : n0);
            }
            for (int q = gw; q < (T + MROWS) / 4; q += NGW) {
                const int m0 = q * 4; const bool ismem = m0 >= T; const float* src = ismem ? a.in[1] + (size_t)(m0 - T) * DM : a.in[0] + (size_t)m0 * DM;
                const f32x4* xr = (const f32x4*)src + lane; f32x4 v[4][4]; float s[4];
#pragma unroll
                for (int r = 0; r < 4; ++r)
#pragma unroll
                    for (int j = 0; j < 4; ++j) v[r][j] = __builtin_nontemporal_load(xr + r * 256 + 64 * j);
#pragma unroll
                for (int r = 0; r < 4; ++r) { s[r] = 0.f;
#pragma unroll
                    for (int j = 0; j < 4; ++j) s[r] += (v[r][j].x * v[r][j].x + v[r][j].y * v[r][j].y) + (v[r][j].z * v[r][j].z + v[r][j].w * v[r][j].w); }
#pragma unroll
                for (int o = 1; o < 64; o <<= 1) { s[0] += __shfl_xor(s[0], o); s[1] += __shfl_xor(s[1], o); s[2] += __shfl_xor(s[2], o); s[3] += __shfl_xor(s[3], o); }
                if (!ismem && lane < 4) SS[m0 + lane] = lane == 0 ? s[0] : lane == 1 ? s[1] : lane == 2 ? s[2] : s[3];
                unsigned long long* o8 = (unsigned long long*)(XB + (size_t)m0 * DM) + lane;
#pragma unroll
                for (int r = 0; r < 4; ++r) { const float sc = ismem ? pg8::rstd_of(s[r]) : 1.f;
#pragma unroll
                    for (int j = 0; j < 4; ++j) { const unsigned long long pk = (unsigned long long)pg8::cvt_pk_bf16(v[r][j].x * sc, v[r][j].y * sc) | ((unsigned long long)pg8::cvt_pk_bf16(v[r][j].z * sc, v[r][j].w * sc) << 32);
                        if (ismem) { const int row = m0 - T + r, k = 4 * (64 * j + lane);
                            *(unsigned long long*)(MEMN + ((size_t)(row >> 5) * 64 + (k >> 4)) * 512 + ((row & 31) + 32 * ((k >> 3) & 1)) * 8 + (k & 7)) = pk; }
                        else o8[r * 256 + 64 * j] = pk; } }
            }
            for (int i = gw * 64 + lane; i < 4 * T; i += NGW * 64) __hip_atomic_store(SS + T + i, 0.f, __ATOMIC_RELAXED, __HIP_MEMORY_SCOPE_AGENT);
    }
    GSYNC();
    GEMM_SCALE(XB, W_AIN, T, 1024, 1024, PROJ, QMA, 1024, 256, 768, C2, SS, (const float*)nullptr, 3);
    {
        int lane; asm volatile("v_mbcnt_lo_u32_b32 %0, -1, 0\n\tv_mbcnt_hi_u32_b32 %0, -1, %0" : "=v"(lane));
        for (int u = gw; u < 2048; u += NGW) mix::memkv_unit(MEMN, W_MKV, MEMK, MEMVT, u, lane);
    }
    GSYNC();
#if REP_MIXA > 1
    for (int rep = 0; rep < REP_MIXA; ++rep)
#endif
    {
            int lane; asm volatile("v_mbcnt_lo_u32_b32 %0, -1, 0\n\tv_mbcnt_hi_u32_b32 %0, -1, %0" : "=v"(lane));
            for (int i = 0; i < 2; ++i) { const int u = gw + NGW * i; if (u < 4096) mix::pool_unit(PROJ, W_GRP + (size_t)((u & 3) ^ (i ? 3 : 0)) * 36864, MIX, (u >> 2) * 32, (u & 3) ^ (i ? 3 : 0), lane); }
            for (int u = gw; u < 4096; u += NGW) mix::mem_unit(QMA, 256, MEMK, MEMVT, MIX, (u >> 2) * 32, u & 3, 0, lane);
    }
    GSYNC();
    GEMM_RESID(true, MIX, W_AOUT, 1024, a.in[0], SS + T);
    GSYNC();
#if REP_UP > 1
    for (int rep = 0; rep < REP_UP; ++rep)
#endif
    GEMM_SWIGLU(XB, W_AGU, SS + T);
    GSYNC();
    GEMM_RESID(false, HB, W_ADOWN, DFF, (const float*)nullptr, SS + 2 * T);
    GSYNC();
    {
        static_assert(WS_XB - WS_W_KQV == (size_t)pg8::KqvOrder::XT0 * 256 * 1024 * 2, "XB tile index relative to W_KQV");
        pg8::Gemm g{W_KQV, W_KQV, 0, 0, 1024}; pg8::KqvOrder S; S.init(G, bx);
        pg8::EpiKqv E{KB, PROJ, VT, SS + 2 * T}; pg8::gemm_phase<pg8::EpiKqv, pg8::KqvOrder, true, true>(lds, g, S, E);
    }
    GSYNC();
#if REP_MIXB > 1
    for (int rep = 0; rep < REP_MIXB; ++rep)
#endif
    {
            int lane; asm volatile("v_mbcnt_lo_u32_b32 %0, -1, 0\n\tv_mbcnt_hi_u32_b32 %0, -1, %0" : "=v"(lane));
            int i = 0;
            for (int u = gw; u < NB * 12 * 128; u += NGW, ++i) { const int bh = u >> 7; int qb = u & 127; if (i & 1) qb = 127 - qb; mix::sb_unit(PROJ, KB, VT, MIX, bh / 12, bh % 12, qb * 32, lane); }
            for (int u = gw; u < 4096; u += NGW) mix::mem_unit(PROJ + 768, 1024, MEMK, MEMVT, MIX, (u >> 2) * 32, u & 3, 1, lane);
    }
    GSYNC();
    GEMM_RESID(false, MIX, W_BOUT, 1024, (const float*)nullptr, SS + 3 * T);
    GSYNC();
    GEMM_SWIGLU(XB, W_BGU, SS + 3 * T);
    GSYNC();
    GEMM_RESID(false, HB, W_BDOWN, DFF, (const float*)nullptr, SS + 4 * T);
    GSYNC();
#if REP_FIN > 1
    for (int rep = 0; rep < REP_FIN; ++rep)
#endif
    {
            int lane; asm volatile("v_mbcnt_lo_u32_b32 %0, -1, 0\n\tv_mbcnt_hi_u32_b32 %0, -1, %0" : "=v"(lane));
            const f32x4* gr = (const f32x4*)a.in[21] + lane; f32x4 gv[4];
#pragma unroll
            for (int j = 0; j < 4; ++j) gv[j] = gr[64 * j];
            for (int q = gw; q < T / 4; q += NGW) { const int m0 = q * 4;
                const f32x4 ss4 = *(const f32x4*)(SS + 4 * T + m0);
                const unsigned long long* xh = (const unsigned long long*)(XB + (size_t)m0 * DM) + lane;
                f32x4* orow = (f32x4*)(a.out + (size_t)m0 * DM) + lane; unsigned long long vh[4][4];
#pragma unroll
                for (int r = 0; r < 4; ++r)
#pragma unroll
                    for (int j = 0; j < 4; ++j) vh[r][j] = __builtin_nontemporal_load(xh + r * 256 + 64 * j);
#pragma unroll
                for (int r = 0; r < 4; ++r) { const float rs = pg8::rstd_of(ss4[r]);
#pragma unroll
                    for (int j = 0; j < 4; ++j) { const unsigned h0 = (unsigned)vh[r][j], h1 = (unsigned)(vh[r][j] >> 32);
                        const f32x4 v = {__uint_as_float(h0 << 16), __uint_as_float(h0 & 0xffff0000u), __uint_as_float(h1 << 16), __uint_as_float(h1 & 0xffff0000u)};
                        __builtin_nontemporal_store(v * gv[j] * rs, orow + r * 256 + 64 * j); } } }
    }
}

extern "C" void kernel_launch(void* const* d_in, const int* in_sizes, int n_in, void* d_out, int out_size, void* d_ws, size_t ws_size, hipStream_t stream) {
    constexpr int LDS_BYTES = 135168;
    static int grid = 0;
    if (grid == 0) {
        if (n_in != 22 || ws_size < WS_END) { fprintf(stderr, "kernel_launch: unexpected inputs (n_in %d, ws %zu)\n", n_in, ws_size); grid = -1; return; }
        int dev = 0, cus = 0, per_cu = 0;
        hipGetDevice(&dev); hipDeviceGetAttribute(&cus, hipDeviceAttributeMultiprocessorCount, dev);
        if (hipFuncSetAttribute((const void*)yoco_fwd, hipFuncAttributeMaxDynamicSharedMemorySize, LDS_BYTES) != hipSuccess) { fprintf(stderr, "kernel_launch: hipFuncSetAttribute failed\n"); }
        if (hipOccupancyMaxActiveBlocksPerMultiprocessor(&per_cu, (const void*)yoco_fwd, 512, LDS_BYTES) != hipSuccess || per_cu < 1) { fprintf(stderr, "kernel_launch: occupancy query says %d\n", per_cu); per_cu = 1; }
        (void)hipGetLastError();
        grid = cus;
    }
    if (grid < 0) return;
    if (hipMemsetAsync(d_ws, 0, 16384, stream) != hipSuccess) { fprintf(stderr, "kernel_launch: memset failed\n"); return; }
    Args a{};
    for (int i = 0; i < 22; ++i) a.in[i] = (const float*)d_in[i];
    a.out = (float*)d_out; a.ws = (unsigned char*)d_ws;
    void* args[] = {&a};
    hipError_t e = hipLaunchCooperativeKernel((const void*)yoco_fwd, dim3(grid), dim3(512), args, LDS_BYTES, stream);
    if (e != hipSuccess) fprintf(stderr, "cooperative launch failed: %s (grid %d)\n", hipGetErrorString(e), grid);
}
```
